# Optimizing an MI355X kernel written in HIP

```python
import jax, jax.numpy as jnp
from jax import lax
import numpy as np

D_MODEL = 2048
BATCH = 2
SEQ = 4096
DEPTH = 4

N_MIXERS = 3
EPS = 1e-6
D_FF = 5504
POOL_WINDOWS = (2, 4, 8, 16)
N_POOL_GROUPS = len(POOL_WINDOWS)
POOL_GROUP = D_MODEL // N_POOL_GROUPS
RET_HEADS = 8
RET_DK = D_MODEL // RET_HEADS
RET_DV = 2 * D_MODEL // RET_HEADS
RET_CHUNK = 128
SWA_HEADS = 32
SWA_KV_HEADS = 4
SWA_HD = 64
SWA_GROUP = SWA_HEADS // SWA_KV_HEADS
SWA_WINDOW = 128
SWA_BLOCK = 128
ROPE_THETA = 10000.0
N_POOL_LAYERS = (DEPTH + 2) // 3
N_RET_LAYERS = (DEPTH + 1) // 3
N_SWA_LAYERS = DEPTH // 3

kernel_name = "hybrid_pool_retention_swa_macaron"


def rms_norm(x, g):
    xf = x.astype(jnp.float32)
    y = xf * lax.rsqrt(jnp.mean(xf * xf, axis=-1, keepdims=True) + EPS)
    return (y * g.astype(jnp.float32)).astype(x.dtype)


def apply_rotary(x, positions, inv_freq):
    ang = positions.astype(jnp.float32)[:, :, None] * inv_freq[None, None, :]
    cos = jnp.cos(ang)[:, :, None, :]
    sin = jnp.sin(ang)[:, :, None, :]
    x1, x2 = jnp.split(x.astype(jnp.float32), 2, axis=-1)
    out = jnp.concatenate([x1 * cos - x2 * sin, x2 * cos + x1 * sin], axis=-1)
    return out.astype(x.dtype)


def swiglu(x, w_in, w_out):
    gate, up = jnp.split(x @ w_in, 2, axis=-1)
    return (jax.nn.silu(gate) * up) @ w_out


def pool_mixer(x, w_group, scale):
    B, S, D = x.shape
    xf = x.astype(jnp.float32).reshape(B, S, N_POOL_GROUPS, POOL_GROUP)
    cs = jnp.pad(jnp.cumsum(xf, axis=1), ((0, 0), (1, 0), (0, 0), (0, 0)))
    t = jnp.arange(1, S + 1)[:, None]
    win = jnp.array(POOL_WINDOWS)[None, :]
    lo = jnp.maximum(t - win, 0)
    cs_lo = cs[:, lo, jnp.arange(N_POOL_GROUPS)[None, :]]
    count = jnp.minimum(t, win).astype(jnp.float32)
    pooled = (cs[:, 1:] - cs_lo) / count[None, :, :, None]
    mixed = (pooled - xf).astype(x.dtype)
    y = jnp.einsum('bsgc,gcd->bsgd', mixed, w_group).reshape(B, S, D)
    return y * scale


def retention_mixer(x, positions, w_in, gn_g, gn_b, w_out):
    B, S, D = x.shape
    N = S // RET_CHUNK
    hproj = x @ w_in
    q, k, v, g = jnp.split(hproj, [D, 2 * D, 4 * D], axis=-1)
    inv_freq = ROPE_THETA ** (-jnp.linspace(0.0, 1.0, RET_DK // 2, dtype=jnp.float32))
    q = apply_rotary(q.reshape(B, S, RET_HEADS, RET_DK), positions, inv_freq)
    k = apply_rotary(k.reshape(B, S, RET_HEADS, RET_DK), positions, inv_freq) * (RET_DK ** -0.5)
    v = v.reshape(B, S, RET_HEADS, RET_DV)

    def to_chunks(t):
        return t.astype(jnp.float32).reshape(B, N, RET_CHUNK, RET_HEADS, t.shape[-1]).transpose(1, 0, 3, 2, 4)

    log_gamma = jnp.log(1.0 - 2.0 ** (-5.0 - jnp.arange(RET_HEADS, dtype=jnp.float32)))
    idx = jnp.arange(RET_CHUNK, dtype=jnp.float32)
    rel = idx[:, None] - idx[None, :]
    inner_decay = jnp.where(rel[None] >= 0, jnp.exp(jnp.maximum(rel, 0.0)[None] * log_gamma[:, None, None]), 0.0)
    cross_decay = jnp.exp((idx + 1.0)[None, :] * log_gamma[:, None])
    state_decay = jnp.exp((RET_CHUNK - 1.0 - idx)[None, :] * log_gamma[:, None])
    chunk_decay = jnp.exp(RET_CHUNK * log_gamma)

    def step(state, qkv):
        qc, kc, vc = qkv
        scores = jnp.einsum('bhid,bhjd->bhij', qc, kc) * inner_decay[None]
        inner = jnp.einsum('bhij,bhjv->bhiv', scores, vc)
        cross = jnp.einsum('bhid,bhdv->bhiv', qc, state) * cross_decay[None, :, :, None]
        new_state = state * chunk_decay[None, :, None, None] + jnp.einsum(
            'bhjd,bhjv->bhdv', kc * state_decay[None, :, :, None], vc)
        return new_state, inner + cross

    state0 = jnp.zeros((B, RET_HEADS, RET_DK, RET_DV), jnp.float32)
    _, o = lax.scan(step, state0, (to_chunks(q), to_chunks(k), to_chunks(v)))
    o = o.transpose(1, 0, 3, 2, 4).reshape(B, S, RET_HEADS, RET_DV)
    mu = jnp.mean(o, axis=-1, keepdims=True)
    var = jnp.mean(jnp.square(o - mu), axis=-1, keepdims=True)
    o = (o - mu) * lax.rsqrt(var + EPS)
    o = o * gn_g.astype(jnp.float32).reshape(RET_HEADS, RET_DV) + gn_b.astype(jnp.float32).reshape(RET_HEADS, RET_DV)
    o = o.reshape(B, S, 2 * D).astype(x.dtype)
    return (jax.nn.silu(g) * o) @ w_out


def swa_mixer(x, positions, w_in, b_in, sinks, w_out, b_out):
    B, S, D = x.shape
    NB = S // SWA_BLOCK
    hproj = x @ w_in + b_in
    q, k, v = jnp.split(hproj, [SWA_HEADS * SWA_HD, (SWA_HEADS + SWA_KV_HEADS) * SWA_HD], axis=-1)
    inv_freq = ROPE_THETA ** (-jnp.arange(0, SWA_HD, 2, dtype=jnp.float32) / SWA_HD)
    q = apply_rotary(q.reshape(B, S, SWA_HEADS, SWA_HD), positions, inv_freq)
    k = apply_rotary(k.reshape(B, S, SWA_KV_HEADS, SWA_HD), positions, inv_freq)
    v = v.reshape(B, S, SWA_KV_HEADS, SWA_HD)

    qb = q.reshape(B, NB, SWA_BLOCK, SWA_KV_HEADS, SWA_GROUP, SWA_HD)

    def band(t):
        prev = jnp.pad(t, ((0, 0), (SWA_BLOCK, 0), (0, 0), (0, 0)))[:, :S]
        shp = (B, NB, SWA_BLOCK, SWA_KV_HEADS, SWA_HD)
        return jnp.concatenate([prev.reshape(shp), t.reshape(shp)], axis=2)

    kb, vb = band(k), band(v)
    i = jnp.arange(SWA_BLOCK)[:, None]
    j = jnp.arange(2 * SWA_BLOCK)[None, :]
    nblk = jnp.arange(NB)[:, None, None]
    diff = i + SWA_BLOCK - j
    key_pos = nblk * SWA_BLOCK - SWA_BLOCK + j
    allowed = (diff >= 0) & (diff < SWA_WINDOW) & (key_pos >= 0)

    scores = jnp.einsum('bnikgd,bnjkd->bnkgij', qb.astype(jnp.float32), kb.astype(jnp.float32)) * (SWA_HD ** -0.5)
    scores = jnp.where(allowed[None, :, None, None], scores, -jnp.inf)
    sink = jnp.broadcast_to(sinks.astype(jnp.float32).reshape(1, 1, SWA_KV_HEADS, SWA_GROUP, 1, 1),
                            scores.shape[:-1] + (1,))
    probs = jax.nn.softmax(jnp.concatenate([scores, sink], axis=-1), axis=-1)[..., :-1]
    out = jnp.einsum('bnkgij,bnjkd->bnikgd', probs, vb.astype(jnp.float32)).astype(x.dtype)
    out = out.reshape(B, S, SWA_HEADS * SWA_HD)
    return out @ w_out + b_out


def setup_inputs(seed: int = 0) -> dict:
    key = jax.random.key(seed)
    ks = jax.random.split(key, 24)
    f32 = jnp.float32

    def nrm(k, shape, fan_in):
        return jax.random.normal(k, shape, f32) * (fan_in ** -0.5)

    def gain(k, shape):
        return 1.0 + 0.05 * jax.random.normal(k, shape, f32)

    x = jax.random.normal(ks[0], (BATCH, SEQ, D_MODEL), f32)
    offsets = jax.random.randint(ks[1], (BATCH, 1), 0, 1024, dtype=jnp.int32)
    positions = offsets + jnp.arange(SEQ, dtype=jnp.int32)[None, :]
    swa_in = (SWA_HEADS + 2 * SWA_KV_HEADS) * SWA_HD
    return {
        "x": x,
        "positions": positions,
        "ln_ffn1": gain(ks[2], (DEPTH, 2, D_MODEL)),
        "ln_mix": gain(ks[3], (DEPTH, 2, D_MODEL)),
        "ln_ffn2": gain(ks[4], (DEPTH, 2, D_MODEL)),
        "ffn_w_in": nrm(ks[5], (DEPTH, 2, D_MODEL, 2 * D_FF), D_MODEL),
        "ffn_w_out": nrm(ks[6], (DEPTH, 2, D_FF, D_MODEL), D_FF),
        "pool_w": nrm(ks[7], (N_POOL_LAYERS, N_POOL_GROUPS, POOL_GROUP, POOL_GROUP), POOL_GROUP),
        "pool_scale": 1.0 + 0.1 * jax.random.normal(ks[8], (N_POOL_LAYERS, D_MODEL), f32),
        "ret_w_in": nrm(ks[9], (N_RET_LAYERS, D_MODEL, 6 * D_MODEL), D_MODEL),
        "ret_gn_g": gain(ks[10], (N_RET_LAYERS, 2 * D_MODEL)),
        "ret_gn_b": 0.02 * jax.random.normal(ks[11], (N_RET_LAYERS, 2 * D_MODEL), f32),
        "ret_w_out": nrm(ks[12], (N_RET_LAYERS, 2 * D_MODEL, D_MODEL), 2 * D_MODEL),
        "swa_w_in": nrm(ks[13], (N_SWA_LAYERS, D_MODEL, swa_in), D_MODEL),
        "swa_b_in": 0.02 * jax.random.normal(ks[14], (N_SWA_LAYERS, swa_in), f32),
        "swa_sinks": 0.5 * jax.random.normal(ks[15], (N_SWA_LAYERS, SWA_HEADS), f32),
        "swa_w_out": nrm(ks[16], (N_SWA_LAYERS, SWA_HEADS * SWA_HD, D_MODEL), SWA_HEADS * SWA_HD),
        "swa_b_out": 0.02 * jax.random.normal(ks[17], (N_SWA_LAYERS, D_MODEL), f32),
    }


def reference(x, positions, ln_ffn1, ln_mix, ln_ffn2, ffn_w_in, ffn_w_out,
              pool_w, pool_scale, ret_w_in, ret_gn_g, ret_gn_b, ret_w_out,
              swa_w_in, swa_b_in, swa_sinks, swa_w_out, swa_b_out):
    h = x
    for i in range(DEPTH):
        f = swiglu(rms_norm(h, ln_ffn1[i, 0]), ffn_w_in[i, 0], ffn_w_out[i, 0])
        h = h + 0.5 * rms_norm(f, ln_ffn1[i, 1])
        u = rms_norm(h, ln_mix[i, 0])
        kind, j = i % N_MIXERS, i // N_MIXERS
        if kind == 0:
            m = pool_mixer(u, pool_w[j], pool_scale[j])
        elif kind == 1:
            m = retention_mixer(u, positions, ret_w_in[j], ret_gn_g[j], ret_gn_b[j], ret_w_out[j])
        else:
            m = swa_mixer(u, positions, swa_w_in[j], swa_b_in[j], swa_sinks[j], swa_w_out[j], swa_b_out[j])
        h = h + rms_norm(m, ln_mix[i, 1])
        f = swiglu(rms_norm(h, ln_ffn2[i, 0]), ffn_w_in[i, 1], ffn_w_out[i, 1])
        h = h + 0.5 * rms_norm(f, ln_ffn2[i, 1])
    return h
```

```cpp
#include <hip/hip_runtime.h>
#include <cstdio>
#include <cstdint>

#ifndef MK_MEGA
#define MK_MEGA 0
#endif

#define LAS __attribute__((address_space(3)))
#define GAS __attribute__((address_space(1)))
typedef unsigned short bf16_t;
typedef short bf16x8 __attribute__((ext_vector_type(8)));
typedef short bf16x4 __attribute__((ext_vector_type(4)));
typedef float f32x4 __attribute__((ext_vector_type(4)));
typedef float f32x2 __attribute__((ext_vector_type(2)));
typedef unsigned u32x4 __attribute__((ext_vector_type(4)));
typedef unsigned u32x2 __attribute__((ext_vector_type(2)));

constexpr int D = 2048, SEQ = 4096, NB = 2, M = NB * SEQ, DFF = 5504, DEPTH = 4;
constexpr float EPS = 1e-6f;
constexpr int RET_N = 6 * D;
constexpr int SWA_N = 2560;

__device__ __forceinline__ unsigned f2bf(float f) { unsigned u = __builtin_bit_cast(unsigned, f); return (u + 0x7fffu + ((u >> 16) & 1u)) >> 16; }
__device__ __forceinline__ unsigned pk2(float lo, float hi) { return f2bf(lo) | (f2bf(hi) << 16); }
__device__ __forceinline__ float bf2f(unsigned short b) { return __builtin_bit_cast(float, (unsigned)b << 16); }
__device__ __forceinline__ float bflo(unsigned w) { return __builtin_bit_cast(float, w << 16); }
__device__ __forceinline__ float bfhi(unsigned w) { return __builtin_bit_cast(float, w & 0xffff0000u); }
__device__ __forceinline__ float wave_sum(float v) {
#pragma unroll
    for (int o = 1; o < 64; o <<= 1) v += __shfl_xor(v, o);
    return v;
}
__device__ __forceinline__ float log2_gamma(int hd) { const float e = ldexpf(1.0f, -5 - hd); float p = 1.0f / 7.0f; p = p * e + 1.0f / 6.0f; p = p * e + 0.2f; p = p * e + 0.25f; p = p * e + 1.0f / 3.0f; p = p * e + 0.5f; p = p * e + 1.0f; return -1.44269504089f * e * p; }
__device__ __forceinline__ float fast_silu(float x) { return x * __builtin_amdgcn_rcpf(1.0f + __builtin_amdgcn_exp2f(-1.44269504089f * x)); }

namespace pg8 {
constexpr int BM = 256, BK = 64, HALF = 128, HTB = HALF * BK * 2, STAGE_BYTES = 8 * HTB, NXCD = 8, WGM = 8;
__host__ __device__ __forceinline__ int lds_byte(int r, int c) { const int st = (r >> 4) * 2 + (c >> 5), rr = r & 15, cc = c & 31, ob = rr * 64 + cc * 2; return st * 1024 + (ob ^ (((ob >> 9) & 1) << 5)); }
__host__ __device__ __forceinline__ void stage_rc(int b, int& R, int& C) { const int st = b / 1024, sb = b % 1024, swz = sb ^ (((sb >> 9) & 1) << 5); R = (st >> 1) * 16 + swz / 64; C = (st & 1) * 32 + (swz % 64) / 2; }
__host__ __device__ __forceinline__ int perm32(int rho) { const int n = rho >> 4, i = rho & 15; return 8 * (i >> 2) + 4 * n + (i & 3); }

struct Unit { int pm, pn, ka; };
struct Gemm { const bf16_t* A; const bf16_t* Bt; int M, N, K, lda, ldb; };

struct StaticOrder {
    int nM, nN, nwg, G, c, kgrp;
    __host__ __device__ void init(int M_, int N_, int G_, int c_, int kgrp_ = 0) { nM = M_ / BM; nN = N_ / BM; nwg = nM * nN; G = G_; c = c_; kgrp = kgrp_; }
    __host__ __device__ bool next(int i, Unit& u) const {
        const long L = (long)i * G + c; if (L >= nwg) return false;
        int wgid = (int)L; { const int q = nwg / NXCD, r = nwg % NXCD, xcd = wgid % NXCD, off = wgid / NXCD; wgid = (xcd < r ? xcd * (q + 1) : r * (q + 1) + (xcd - r) * q) + off; }
        const int nig = WGM * nN, gid = wgid / nig, fm = gid * WGM, gsz = (nM - fm) < WGM ? (nM - fm) : WGM;
        u.pm = fm + ((wgid % nig) % gsz); u.pn = (wgid % nig) / gsz; u.ka = kgrp ? (u.pn >> 1) * kgrp : 0; return true;
    }
    __device__ __forceinline__ void a_ready(const Unit&) const {}
    __device__ __forceinline__ void done(const Unit&) const {}
};

struct EpiF32 {
    static constexpr bool PERM = false;
    float* C; int ldc; const float* bias; const float* scale;
    __device__ __forceinline__ void operator()(const f32x4 (&acc)[2][2][4][2], const Unit& u, int wr, int wc, int fr, int fq) const {
        const int row0 = u.pm * BM + wr * 64 + fr, col0 = u.pn * BM + wc * 32 + 4 * fq;
        f32x4 bv[2][2], sv[2][2];
#pragma unroll
        for (int bj = 0; bj < 2; ++bj)
#pragma unroll
            for (int n = 0; n < 2; ++n) { bv[bj][n] = bias ? *(const f32x4*)(bias + col0 + bj * HALF + n * 16) : (f32x4){0.f, 0.f, 0.f, 0.f};
                                          sv[bj][n] = scale ? *(const f32x4*)(scale + col0 + bj * HALF + n * 16) : (f32x4){1.f, 1.f, 1.f, 1.f}; }
#pragma unroll
        for (int ai = 0; ai < 2; ++ai)
#pragma unroll
            for (int m = 0; m < 4; ++m) { float* rowp = C + (size_t)(row0 + ai * HALF + m * 16) * ldc + col0;
#pragma unroll
                for (int bj = 0; bj < 2; ++bj)
#pragma unroll
                    for (int n = 0; n < 2; ++n) *(f32x4*)(rowp + bj * HALF + n * 16) = (acc[ai][bj][m][n] + bv[bj][n]) * sv[bj][n]; }
    }
};
struct EpiSwiglu {
    static constexpr bool PERM = true;
    bf16_t* O; int ldc;
    __device__ __forceinline__ void operator()(const f32x4 (&acc)[2][2][4][2], const Unit& u, int wr, int wc, int fr, int fq) const {
        const int row0 = u.pm * BM + wr * 64 + fr, col0 = u.pn * HALF + wc * 32 + 8 * fq;
#pragma unroll
        for (int ai = 0; ai < 2; ++ai)
#pragma unroll
            for (int m = 0; m < 4; ++m) {
                const f32x4 g0 = acc[ai][0][m][0], g1 = acc[ai][0][m][1], u0 = acc[ai][1][m][0], u1 = acc[ai][1][m][1];
                u32x4 w;
                w.x = pk2(fast_silu(g0[0]) * u0[0], fast_silu(g0[1]) * u0[1]); w.y = pk2(fast_silu(g0[2]) * u0[2], fast_silu(g0[3]) * u0[3]);
                w.z = pk2(fast_silu(g1[0]) * u1[0], fast_silu(g1[1]) * u1[1]); w.w = pk2(fast_silu(g1[2]) * u1[2], fast_silu(g1[3]) * u1[3]);
                *(u32x4*)(O + (size_t)(row0 + ai * HALF + m * 16) * ldc + col0) = w; }
    }
};
struct EpiRetIn {
    static constexpr bool PERM = true;
    bf16_t* O; const float* cs; const float* sn;
    __device__ __forceinline__ void operator()(const f32x4 (&acc)[2][2][4][2], const Unit& u, int wr, int wc, int fr, int fq) const {
        const int row0 = u.pm * BM + wr * 64 + fr, j0 = wc * 32 + 8 * fq;
        if (u.pn < 16) {
            const int hd = u.pn & 7; const bool isq = u.pn < 8;
            const float l2g = log2_gamma(hd);
#pragma unroll
            for (int ai = 0; ai < 2; ++ai)
#pragma unroll
                for (int m = 0; m < 4; ++m) { const int row = row0 + ai * HALF + m * 16; const int ic = row & 127;
                    const float dsc = isq ? __builtin_amdgcn_exp2f(l2g * (float)ic) : 0.0625f * __builtin_amdgcn_exp2f(-l2g * (float)ic);
                    const f32x4 c0 = *(const f32x4*)(cs + (size_t)row * 128 + j0), c1 = *(const f32x4*)(cs + (size_t)row * 128 + j0 + 4);
                    const f32x4 s0 = *(const f32x4*)(sn + (size_t)row * 128 + j0), s1 = *(const f32x4*)(sn + (size_t)row * 128 + j0 + 4);
                    const f32x4 a0 = acc[ai][0][m][0], a1 = acc[ai][0][m][1], b0 = acc[ai][1][m][0], b1 = acc[ai][1][m][1];
                    const f32x4 x0 = (a0 * c0 - b0 * s0) * dsc, x1 = (a1 * c1 - b1 * s1) * dsc, y0 = (b0 * c0 + a0 * s0) * dsc, y1 = (b1 * c1 + a1 * s1) * dsc;
                    u32x4 w0, w1; w0.x = pk2(x0[0], x0[1]); w0.y = pk2(x0[2], x0[3]); w0.z = pk2(x1[0], x1[1]); w0.w = pk2(x1[2], x1[3]);
                    w1.x = pk2(y0[0], y0[1]); w1.y = pk2(y0[2], y0[3]); w1.z = pk2(y1[0], y1[1]); w1.w = pk2(y1[2], y1[3]);
                    bf16_t* rowp = O + (size_t)row * RET_N + u.pn * BM + j0;
                    *(u32x4*)(rowp) = w0; *(u32x4*)(rowp + HALF) = w1; }
        } else {
#pragma unroll
            for (int ai = 0; ai < 2; ++ai)
#pragma unroll
                for (int m = 0; m < 4; ++m) { bf16_t* rowp = O + (size_t)(row0 + ai * HALF + m * 16) * RET_N + u.pn * BM + j0;
#pragma unroll
                    for (int bj = 0; bj < 2; ++bj) { const f32x4 v0 = acc[ai][bj][m][0], v1 = acc[ai][bj][m][1];
                        u32x4 w; w.x = pk2(v0[0], v0[1]); w.y = pk2(v0[2], v0[3]); w.z = pk2(v1[0], v1[1]); w.w = pk2(v1[2], v1[3]);
                        *(u32x4*)(rowp + bj * HALF) = w; } }
        }
    }
};
struct EpiSwaIn {
    static constexpr bool PERM = true;
    bf16_t* O; const float* bias; const float* cs; const float* sn;
    __device__ __forceinline__ void operator()(const f32x4 (&acc)[2][2][4][2], const Unit& u, int wr, int wc, int fr, int fq) const {
        const int row0 = u.pm * BM + wr * 64 + fr, j0 = 8 * fq, cbase = u.pn * BM + 64 * wc;
        const f32x4 ba0 = *(const f32x4*)(bias + cbase + j0), ba1 = *(const f32x4*)(bias + cbase + j0 + 4), bb0 = *(const f32x4*)(bias + cbase + 32 + j0), bb1 = *(const f32x4*)(bias + cbase + 32 + j0 + 4);
        const bool rot = u.pn < 9;
#pragma unroll
        for (int ai = 0; ai < 2; ++ai)
#pragma unroll
            for (int m = 0; m < 4; ++m) { const int row = row0 + ai * HALF + m * 16;
                f32x4 c0 = (f32x4){1.f, 1.f, 1.f, 1.f}, c1 = c0, s0 = (f32x4){0.f, 0.f, 0.f, 0.f}, s1 = s0;
                if (rot) { c0 = *(const f32x4*)(cs + (size_t)row * 32 + j0); c1 = *(const f32x4*)(cs + (size_t)row * 32 + j0 + 4); s0 = *(const f32x4*)(sn + (size_t)row * 32 + j0); s1 = *(const f32x4*)(sn + (size_t)row * 32 + j0 + 4); }
                const f32x4 a0 = acc[ai][0][m][0] + ba0, a1 = acc[ai][0][m][1] + ba1, b0 = acc[ai][1][m][0] + bb0, b1 = acc[ai][1][m][1] + bb1;
                const f32x4 x0 = a0 * c0 - b0 * s0, x1 = a1 * c1 - b1 * s1, y0 = b0 * c0 + a0 * s0, y1 = b1 * c1 + a1 * s1;
                u32x4 w0, w1; w0.x = pk2(x0[0], x0[1]); w0.y = pk2(x0[2], x0[3]); w0.z = pk2(x1[0], x1[1]); w0.w = pk2(x1[2], x1[3]);
                w1.x = pk2(y0[0], y0[1]); w1.y = pk2(y0[2], y0[3]); w1.z = pk2(y1[0], y1[1]); w1.w = pk2(y1[2], y1[3]);
                bf16_t* rowp = O + (size_t)row * SWA_N + cbase + j0;
                *(u32x4*)(rowp) = w0; *(u32x4*)(rowp + 32) = w1; }
    }
};

template <class Epi, class Sched>
__device__ __forceinline__ void gemm_phase(LAS unsigned char* lds, const Gemm g, const Sched& S, const Epi& E) {
    int tid_ = threadIdx.x; asm volatile("" : "+v"(tid_));
    const int tid = tid_, wid = __builtin_amdgcn_readfirstlane(tid >> 6), lane = tid & 63, wr = wid >> 2, wc = wid & 3, fr = lane & 15, fq = lane >> 4;
    const int K = g.K, nt = K / BK;
    unsigned voffA[2], voffB[2];
#pragma unroll
    for (int i = 0; i < 2; ++i) { int R, C; stage_rc(tid * 16 + i * 8192, R, C); const int Rb = Epi::PERM ? ((R & ~31) + perm32(R & 31)) : R;
        voffA[i] = (unsigned)(R * g.lda + C) * 2u; voffB[i] = (unsigned)(Rb * g.ldb + C) * 2u; }
    const size_t kstep = (size_t)(BK * 2);
    const size_t hstepA = (size_t)HALF * g.lda * 2, hstepB = (size_t)HALF * g.ldb * 2;
    const size_t tstepA = 2 * hstepA, tstepB = 2 * hstepB;
    const unsigned ldsw = (unsigned)wid * 1024u;
    const int aoff = lds_byte(wr * 64 + fr, fq * 8), boff = lds_byte(wc * 32 + fr, fq * 8);
#define PG8_SA(b, h) (((b) * 2 + (h)) * HTB)
#define PG8_SB(b, h) ((4 + (b) * 2 + (h)) * HTB)
#define PG8_STAGE(bufoff, gbase, voff) do { _Pragma("unroll") for (int _i = 0; _i < 2; ++_i) \
        __builtin_amdgcn_global_load_lds((const unsigned*)((const char*)(gbase) + (voff)[_i]), (LAS unsigned*)(lds + (bufoff) + ldsw + _i * 8192), 16, 0, 0); } while (0)
#define PG8_LDA(dst, b, h) do { _Pragma("unroll") for (int m = 0; m < 4; ++m) _Pragma("unroll") for (int k = 0; k < 2; ++k) dst[m][k] = *(const LAS bf16x8*)(lds + PG8_SA(b, h) + aoff + m * 2048 + k * 1024); } while (0)
#define PG8_LDB(dst, b, h) do { _Pragma("unroll") for (int n = 0; n < 2; ++n) _Pragma("unroll") for (int k = 0; k < 2; ++k) dst[n][k] = *(const LAS bf16x8*)(lds + PG8_SB(b, h) + boff + n * 2048 + k * 1024); } while (0)
#define PG8_MMA(ai, bj, At, Bt) do { __builtin_amdgcn_s_setprio(1); _Pragma("unroll") for (int m = 0; m < 4; ++m) _Pragma("unroll") for (int n = 0; n < 2; ++n) _Pragma("unroll") for (int k = 0; k < 2; ++k) \
        acc[ai][bj][m][n] = __builtin_amdgcn_mfma_f32_16x16x32_bf16(Bt[n][k], At[m][k], acc[ai][bj][m][n], 0, 0, 0); __builtin_amdgcn_s_setprio(0); } while (0)
#define PG8_WAIT_V(n) asm volatile("s_waitcnt vmcnt(" #n ")" ::: "memory")
#define PG8_WAIT_L(n) asm volatile("s_waitcnt lgkmcnt(" #n ")" ::: "memory")
#define PG8_BAR __builtin_amdgcn_s_barrier()
#define PG8_SCHED __builtin_amdgcn_sched_barrier(0)
    Unit cur, nxt; int ui = 0;
    if (!S.next(0, cur)) return;
    f32x4 acc[2][2][4][2];
#pragma unroll
    for (int a = 0; a < 2; ++a)
#pragma unroll
        for (int b = 0; b < 2; ++b)
#pragma unroll
            for (int m = 0; m < 4; ++m)
#pragma unroll
                for (int n = 0; n < 2; ++n) acc[a][b][m][n] = (f32x4){0.f, 0.f, 0.f, 0.f};
    bf16x8 At[4][2], B0[2][2], B1[2][2];
    const char* cA = (const char*)g.A + (size_t)cur.pm * tstepA + (size_t)cur.ka * 2; const char* cB = (const char*)g.Bt + (size_t)cur.pn * tstepB;
    S.a_ready(cur);
    PG8_STAGE(PG8_SB(0, 0), cB, voffB); PG8_STAGE(PG8_SB(0, 1), cB + hstepB, voffB); PG8_STAGE(PG8_SA(0, 0), cA, voffA); PG8_STAGE(PG8_SA(0, 1), cA + hstepA, voffA);
    if (wr == 1) PG8_BAR;
    PG8_WAIT_V(2); PG8_BAR;
    PG8_STAGE(PG8_SB(1, 0), cB + kstep, voffB); PG8_STAGE(PG8_SA(1, 0), cA + kstep, voffA); PG8_STAGE(PG8_SB(1, 1), cB + hstepB + kstep, voffB);
    PG8_WAIT_V(6); PG8_BAR;
    for (;;) {
        const bool has_next = S.next(ui + 1, nxt);
        const char* nA = has_next ? (const char*)g.A + (size_t)nxt.pm * tstepA + (size_t)nxt.ka * 2 : cA; const char* nB = has_next ? (const char*)g.Bt + (size_t)nxt.pn * tstepB : cB;
        for (int t = 0; t < nt; t += 2) {
            const bool last = (t == nt - 2);
            const char* a1 = cA + (size_t)(t + 1) * kstep;
            const char* a2 = last ? nA : cA + (size_t)(t + 2) * kstep; const char* b2 = last ? nB : cB + (size_t)(t + 2) * kstep;
            const char* a3 = a2 + kstep; const char* b3 = b2 + kstep;
            if (last && has_next) S.a_ready(nxt);
            PG8_LDB(B0, 0, 0); PG8_LDB(B1, 0, 1); PG8_SCHED; PG8_LDA(At, 0, 0); PG8_STAGE(PG8_SA(1, 1), a1 + hstepA, voffA);
            PG8_WAIT_V(8); PG8_WAIT_L(0); PG8_BAR; PG8_MMA(0, 0, At, B0); PG8_MMA(0, 1, At, B1); PG8_BAR; PG8_SCHED;
            PG8_LDA(At, 0, 1); PG8_STAGE(PG8_SB(0, 0), b2, voffB); PG8_STAGE(PG8_SB(0, 1), b2 + hstepB, voffB); PG8_STAGE(PG8_SA(0, 0), a2, voffA);
            PG8_WAIT_V(8); PG8_WAIT_L(0); PG8_BAR; PG8_MMA(1, 0, At, B0); PG8_MMA(1, 1, At, B1); PG8_BAR; PG8_SCHED;
            PG8_LDB(B0, 1, 0); PG8_LDB(B1, 1, 1); PG8_SCHED; PG8_LDA(At, 1, 0); PG8_STAGE(PG8_SA(0, 1), a2 + hstepA, voffA);
            PG8_WAIT_V(8); PG8_WAIT_L(0); PG8_BAR; PG8_MMA(0, 0, At, B0); PG8_MMA(0, 1, At, B1); PG8_BAR; PG8_SCHED;
            PG8_LDA(At, 1, 1); PG8_STAGE(PG8_SB(1, 0), b3, voffB); PG8_STAGE(PG8_SB(1, 1), b3 + hstepB, voffB); PG8_STAGE(PG8_SA(1, 0), a3, voffA);
            PG8_WAIT_V(8); PG8_WAIT_L(0); PG8_BAR; PG8_MMA(1, 0, At, B0); PG8_MMA(1, 1, At, B1); PG8_BAR; PG8_SCHED;
        }
        if (wr == 0) PG8_BAR;
        E(acc, cur, wr, wc, fr, fq); S.done(cur);
        if (!has_next) break;
#pragma unroll
        for (int a = 0; a < 2; ++a)
#pragma unroll
            for (int b = 0; b < 2; ++b)
#pragma unroll
                for (int m = 0; m < 4; ++m)
#pragma unroll
                    for (int n = 0; n < 2; ++n) acc[a][b][m][n] = (f32x4){0.f, 0.f, 0.f, 0.f};
        cur = nxt; cA = nA; cB = nB; ++ui;
        if (wr == 1) PG8_BAR;
    }
    PG8_WAIT_V(0);
    PG8_BAR;
#undef PG8_SA
#undef PG8_SB
#undef PG8_STAGE
#undef PG8_LDA
#undef PG8_LDB
#undef PG8_MMA
#undef PG8_WAIT_V
#undef PG8_WAIT_L
#undef PG8_BAR
#undef PG8_SCHED
}
}

constexpr size_t MiB = 1u << 20;
constexpr size_t WS_CTL = 0, CTL_ZERO_BYTES = 1 * MiB;
constexpr size_t WS_RCOS = 2 * MiB, WS_RSIN = 6 * MiB, WS_SCOS = 10 * MiB, WS_SSIN = 11 * MiB;
constexpr size_t WS_H = 16 * MiB;
constexpr size_t WS_F = 80 * MiB;
constexpr size_t WS_U = 144 * MiB;
constexpr size_t WS_X2 = 176 * MiB;
constexpr size_t WS_BIG = 208 * MiB;
constexpr size_t WS_RO = 400 * MiB;
constexpr size_t WS_GT = 464 * MiB;
constexpr size_t WS_W = 528 * MiB;
constexpr size_t W_FFIN_SZ = (size_t)2 * DFF * D * 2, W_FFOUT_SZ = (size_t)D * DFF * 2;
constexpr size_t WS_WFFIN = WS_W, WS_WFFOUT = WS_WFFIN + 8 * W_FFIN_SZ, WS_WPOOL = WS_WFFOUT + 8 * W_FFOUT_SZ;
constexpr size_t WS_WRIN = WS_WPOOL + (size_t)2 * D * 512 * 2, WS_WROUT = WS_WRIN + (size_t)RET_N * D * 2, WS_WSIN = WS_WROUT + (size_t)D * 4096 * 2, WS_WSOUT = WS_WSIN + (size_t)SWA_N * D * 2;
constexpr size_t WS_END = WS_WSOUT + (size_t)D * D * 2;
constexpr int CW_BAR = 4096;

constexpr int RING_BYTES = 131072, MISC_OFF = RING_BYTES + 320, LDS_BYTES = 147456;

#define XB_TMO      128
#define XB_XCNT(j)  (256  + 64 * (j))
#define XB_XSUB(j)  (1280 + 64 * (j))
#define XB_XGEN(j)  (2304 + 64 * (j))
#define XB_TOP      3328
#define XB_TOPGEN   3392
#define XCD_BAR_WORDS 3456
#define XB_SPIN_CAP (1u << 18)
__device__ __forceinline__ unsigned xb_ld(unsigned* p)              { return __hip_atomic_load(p, __ATOMIC_RELAXED, __HIP_MEMORY_SCOPE_AGENT); }
__device__ __forceinline__ unsigned xb_add(unsigned* p, unsigned v) { return __hip_atomic_fetch_add(p, v, __ATOMIC_RELAXED, __HIP_MEMORY_SCOPE_AGENT); }
__device__ __forceinline__ unsigned xb_xcc_id() { return (unsigned)__builtin_amdgcn_s_getreg((3 << 11) | 20) & 0xFu; }
#define XB_SPIN(cond, bar) do { unsigned _sp = 0; while (cond) { __builtin_amdgcn_s_sleep(1); \
    if ((++_sp & 255u) == 0u) { if (xb_ld(&(bar)[XB_TMO])) break; if (_sp > XB_SPIN_CAP) { atomicAdd(&(bar)[XB_TMO], 1u); break; } } } } while (0)
struct XcdBarrier { unsigned* bar; unsigned x; volatile LAS unsigned* st; };
__device__ __forceinline__ XcdBarrier xcd_barrier_post(unsigned* bar, volatile LAS unsigned* st) {
    XcdBarrier b; b.bar = bar; b.x = xb_xcc_id(); b.st = st;
    if (threadIdx.x == 0) (void)xb_add(&bar[XB_XCNT(b.x)], 1u);
    return b;
}
__device__ __forceinline__ void xcd_barrier_complete(unsigned* bar, unsigned x, unsigned& nloc, unsigned& nx) {
    const unsigned G = gridDim.x * gridDim.y * gridDim.z;
    unsigned sum, cnt, mine, sp = 0u;
    for (;;) {
        sum = 0u; cnt = 0u; mine = 0u;
#pragma unroll
        for (unsigned j = 0; j < 16; ++j) { const unsigned c = xb_ld(&bar[XB_XCNT(j)]); sum += c; cnt += (c > 0u) ? 1u : 0u; mine = (j == x) ? c : mine; }
        if (sum == G) break;
        __builtin_amdgcn_s_sleep(1);
        if ((++sp & 255u) == 0u) { if (xb_ld(&bar[XB_TMO])) break; if (sp > XB_SPIN_CAP) { atomicAdd(&bar[XB_TMO], 1u); break; } }
    }
    nloc = mine > 0u ? mine : 1u; nx = cnt > 0u ? cnt : 1u;
}
__device__ __forceinline__ void xcd_barrier(const XcdBarrier& b) {
    asm volatile("s_waitcnt vmcnt(0)" ::: "memory");
    __syncthreads();
    if (threadIdx.x == 0) {
        unsigned* bar = b.bar;
        __builtin_amdgcn_s_waitcnt(0);
        unsigned nloc = b.st[0], nx = b.st[1];
        if (nloc == 0u) { xcd_barrier_complete(bar, b.x, nloc, nx); b.st[0] = nloc; b.st[1] = nx; }
        const unsigned old = xb_add(&bar[XB_XSUB(b.x)], 1u);
        const unsigned gen = old / nloc;
        if (old + 1u == (gen + 1u) * nloc) {
            __builtin_amdgcn_fence(__ATOMIC_RELEASE, "agent");
            asm volatile("s_waitcnt vmcnt(0)" ::: "memory");
            const unsigned og = xb_add(&bar[XB_TOP], 1u);
            const unsigned tg = og / nx;
            if (og + 1u == (tg + 1u) * nx) xb_add(&bar[XB_TOPGEN], 1u);
            else XB_SPIN(xb_ld(&bar[XB_TOPGEN]) == tg, bar);
            __builtin_amdgcn_fence(__ATOMIC_ACQUIRE, "agent");
            xb_add(&bar[XB_XGEN(b.x)], 1u);
            asm volatile("s_waitcnt vmcnt(0)" ::: "memory");
        } else {
            XB_SPIN(xb_ld(&bar[XB_XGEN(b.x)]) == gen, bar);
            __builtin_amdgcn_fence(__ATOMIC_ACQUIRE, "agent");
            asm volatile("s_waitcnt vmcnt(0)" ::: "memory");
        }
    }
    __syncthreads();
}

struct Frame {
    LAS unsigned char* lds;
    int tid, lane, wave, vcu, G;
};
#define LDS_WAIT() asm volatile("s_waitcnt lgkmcnt(0)" ::: "memory")
__device__ __forceinline__ Frame relaunder(const Frame& F0) { Frame F = F0; int t = threadIdx.x; asm volatile("" : "+v"(t)); F.tid = t; F.lane = t & 63; F.wave = __builtin_amdgcn_readfirstlane(t >> 6); return F; }

__device__ __forceinline__ void transpose_item(const float* W, int K, int N, bf16_t* WT, int k0, int n0, int drow0, LAS float* scr, int lane) {
#pragma unroll 8
    for (int i = 0; i < 32; ++i) { const int kk = 2 * i + (lane >> 5); scr[kk * 33 + (lane & 31)] = W[(size_t)(k0 + kk) * N + n0 + (lane & 31)]; }
    LDS_WAIT(); asm volatile("" ::: "memory");
    const int c = lane & 7;
#pragma unroll
    for (int j = 0; j < 4; ++j) { const int n = (lane >> 3) + 8 * j; const LAS float* s = scr + (8 * c) * 33 + n;
        u32x4 o; o.x = pk2(s[0 * 33], s[1 * 33]); o.y = pk2(s[2 * 33], s[3 * 33]); o.z = pk2(s[4 * 33], s[5 * 33]); o.w = pk2(s[6 * 33], s[7 * 33]);
        *(u32x4*)(WT + (size_t)(drow0 + n) * K + k0 + 8 * c) = o; }
    LDS_WAIT(); asm volatile("" ::: "memory");
}
__device__ __forceinline__ void convert_stack(const Frame& F0, const float* W, bf16_t* WT, int nmat, int K, int N, int mode) {
    const Frame F = relaunder(F0);
    LAS float* scr = (LAS float*)(F.lds + F.wave * 16384);
    const int gw = F.vcu * 8 + F.wave, NGW = F.G * 8;
    const int nblk = N / 32, per = (K / 64) * nblk, total = nmat * per;
    for (int it = gw; it < total; it += NGW) {
        const int mi = it / per, r = it - mi * per, kb = r / nblk, nb = r - kb * nblk, n0 = 32 * nb;
        int drow0 = n0;
        if (mode == 1) { const int hn = N / 2; drow0 = (n0 < hn) ? ((n0 >> 7) * 256 + (n0 & 127)) : (((n0 - hn) >> 7) * 256 + 128 + ((n0 - hn) & 127)); }
        else if (mode == 2) { const int t = n0 >> 8, w = n0 & 255; drow0 = t * 256 + ((w >> 5) & 1) * 128 + (w >> 6) * 32; }
        transpose_item(W + (size_t)mi * K * N, K, N, WT + (size_t)mi * K * N, 64 * kb, n0, drow0, scr, F.lane);
    }
}
__device__ __forceinline__ void sincos_dd(double ang, float& s, float& c) {
    const double q = rint(ang * 0.63661977236758134308);
    double r = fma(-q, 1.57079632679489655800e+00, ang); r = fma(-q, 6.12323399573676603587e-17, r);
    const int qi = (int)((long long)q & 3);
    const double r2 = r * r;
    double sp = -1.0 / 1307674368000.0; sp = fma(sp, r2, 1.0 / 6227020800.0); sp = fma(sp, r2, -1.0 / 39916800.0); sp = fma(sp, r2, 1.0 / 362880.0); sp = fma(sp, r2, -1.0 / 5040.0); sp = fma(sp, r2, 1.0 / 120.0); sp = fma(sp, r2, -1.0 / 6.0); sp = fma(sp * r2, r, r);
    double cp = 1.0 / 20922789888000.0; cp = fma(cp, r2, -1.0 / 87178291200.0); cp = fma(cp, r2, 1.0 / 479001600.0); cp = fma(cp, r2, -1.0 / 3628800.0); cp = fma(cp, r2, 1.0 / 40320.0); cp = fma(cp, r2, -1.0 / 720.0); cp = fma(cp, r2, 1.0 / 24.0); cp = fma(cp, r2, -0.5); cp = fma(cp, r2, 1.0);
    const double ss = (qi & 1) ? cp : sp, cc = (qi & 1) ? sp : cp;
    s = (float)((qi & 2) ? -ss : ss); c = (float)(((qi + 1) & 2) ? -cc : cc);
}
__device__ __forceinline__ void rope_tables(const Frame& F0, const int* pos, float* rc, float* rs, float* sc, float* ss) {
    const Frame F = relaunder(F0);
    const int gt = F.vcu * 512 + F.tid, NT = F.G * 512;
    for (int i = gt; i < M * 160; i += NT) {
        const int row = i / 160, j = i - row * 160;
        const double p = (double)pos[row];
        float s, c;
        if (j < 128) { const double invf = exp2(-(double)j * (13.287712379549449 / 127.0)); sincos_dd(p * invf, s, c); rc[(size_t)row * 128 + j] = c; rs[(size_t)row * 128 + j] = s; }
        else { const int jj = j - 128; const double invf = exp2(-(double)jj * (13.287712379549449 / 32.0)); sincos_dd(p * invf, s, c); sc[(size_t)row * 32 + jj] = c; ss[(size_t)row * 32 + jj] = s; }
    }
}

__device__ __forceinline__ void norm_phase(const Frame& F0, const float* hin, float* hout, const float* f, float alpha, const float* g1, const float* g2, bf16_t* u) {
    const Frame F = relaunder(F0);
    const int gw = F.vcu * 8 + F.wave, NGW = F.G * 8;
    for (int row = gw; row < M; row += NGW) {
        const f32x4* hr = (const f32x4*)(hin + (size_t)row * D) + F.lane;
        f32x4 hv[8];
#pragma unroll
        for (int j = 0; j < 8; ++j) hv[j] = hr[64 * j];
        if (f) {
            const f32x4* fr = (const f32x4*)(f + (size_t)row * D) + F.lane;
            f32x4 fv[8]; float ss = 0.f;
#pragma unroll
            for (int j = 0; j < 8; ++j) { fv[j] = fr[64 * j]; ss += (fv[j].x * fv[j].x + fv[j].y * fv[j].y) + (fv[j].z * fv[j].z + fv[j].w * fv[j].w); }
            const float rstd = alpha / sqrtf(wave_sum(ss) * (1.0f / D) + EPS);
#pragma unroll
            for (int j = 0; j < 8; ++j) { const f32x4 gv = ((const f32x4*)g1)[F.lane + 64 * j]; hv[j] = hv[j] + fv[j] * gv * rstd; }
        }
        if (hout) { f32x4* ho = (f32x4*)(hout + (size_t)row * D) + F.lane;
#pragma unroll
            for (int j = 0; j < 8; ++j) ho[64 * j] = hv[j]; }
        if (g2) {
            float ss = 0.f;
#pragma unroll
            for (int j = 0; j < 8; ++j) ss += (hv[j].x * hv[j].x + hv[j].y * hv[j].y) + (hv[j].z * hv[j].z + hv[j].w * hv[j].w);
            const float rstd = 1.0f / sqrtf(wave_sum(ss) * (1.0f / D) + EPS);
            u32x2* uo = (u32x2*)(u + (size_t)row * D) + F.lane;
#pragma unroll
            for (int j = 0; j < 8; ++j) { const f32x4 gv = ((const f32x4*)g2)[F.lane + 64 * j]; const f32x4 y = hv[j] * gv * rstd; u32x2 w; w.x = pk2(y.x, y.y); w.y = pk2(y.z, y.w); uo[64 * j] = w; }
        }
    }
}

__device__ __forceinline__ void pool_phase(const Frame& F0, const bf16_t* u, bf16_t* mixed) {
    const Frame F = relaunder(F0);
    const int gt = F.vcu * 512 + F.tid, NT = F.G * 512;
    for (int i = gt; i < M * (D / 8); i += NT) {
        const int row = i >> 8, c8 = i & 255, s = row & (SEQ - 1), w = 2 << (c8 >> 6);
        const int cnt = (s + 1 < w) ? (s + 1) : w;
        float a[8];
#pragma unroll
        for (int e = 0; e < 8; ++e) a[e] = 0.f;
        u32x4 self = (u32x4){0u, 0u, 0u, 0u};
        for (int k = 0; k < cnt; ++k) { const u32x4 v = *(const u32x4*)(u + (size_t)(row - k) * D + c8 * 8); if (k == 0) self = v;
            a[0] += bflo(v.x); a[1] += bfhi(v.x); a[2] += bflo(v.y); a[3] += bfhi(v.y); a[4] += bflo(v.z); a[5] += bfhi(v.z); a[6] += bflo(v.w); a[7] += bfhi(v.w); }
        const float inv = 1.0f / (float)cnt;
        u32x4 o;
        o.x = pk2(a[0] * inv - bflo(self.x), a[1] * inv - bfhi(self.x)); o.y = pk2(a[2] * inv - bflo(self.y), a[3] * inv - bfhi(self.y));
        o.z = pk2(a[4] * inv - bflo(self.z), a[5] * inv - bfhi(self.z)); o.w = pk2(a[6] * inv - bflo(self.w), a[7] * inv - bfhi(self.w));
        *(u32x4*)(mixed + (size_t)row * D + c8 * 8) = o;
    }
}

__device__ __forceinline__ void ds_tr4(unsigned a0, unsigned a1, unsigned a2, unsigned a3, bf16x8& f0, bf16x8& f1) {
    bf16x4 r0, r1, r2, r3;
    asm volatile("ds_read_b64_tr_b16 %0, %4\n\tds_read_b64_tr_b16 %1, %5\n\tds_read_b64_tr_b16 %2, %6\n\tds_read_b64_tr_b16 %3, %7\n\ts_waitcnt lgkmcnt(0)"
                 : "=&v"(r0), "=&v"(r1), "=&v"(r2), "=&v"(r3) : "v"(a0), "v"(a1), "v"(a2), "v"(a3) : "memory");
    f0 = __builtin_shufflevector(r0, r1, 0, 1, 2, 3, 4, 5, 6, 7); f1 = __builtin_shufflevector(r2, r3, 0, 1, 2, 3, 4, 5, 6, 7);
}
__device__ __forceinline__ bf16x8 pack8(const f32x4& a, const f32x4& b) {
    u32x4 w; w.x = pk2(a[0], a[1]); w.y = pk2(a[2], a[3]); w.z = pk2(b[0], b[1]); w.w = pk2(b[2], b[3]);
    return __builtin_bit_cast(bf16x8, w);
}

constexpr int RK_STR = 528, RV_STR = 80;
constexpr int R_KS = 0, R_VS = 128 * RK_STR, R_ST = R_VS + 128 * RV_STR, R_END = R_ST + 32 * RK_STR;
static_assert(R_END <= RING_BYTES, "retention LDS");
__device__ __forceinline__ void ret_core_phase(const Frame& F0, const bf16_t* hp, bf16_t* ro) {
    const Frame F = relaunder(F0);
    const int w = F.wave, lane = F.lane, l15 = lane & 15, g = lane >> 4, q = (lane & 15) >> 2, p = lane & 3;
    const unsigned ldsb = (unsigned)(size_t)F.lds;
    for (int item = F.vcu; item < 256; item += F.G) {
        const int b = item >> 7, hd = (item >> 4) & 7, vs = item & 15;
        const float l2g = log2_gamma(hd);
        const float g128 = __builtin_amdgcn_exp2f(128.0f * l2g);
        const bf16_t* qb = hp + (size_t)(b * SEQ) * RET_N + hd * 256;
        const bf16_t* kb = hp + (size_t)(b * SEQ) * RET_N + D + hd * 256;
        const bf16_t* vb = hp + (size_t)(b * SEQ) * RET_N + 2 * D + hd * 512 + vs * 32;
        bf16_t* ob = ro + (size_t)(b * SEQ) * 4096 + hd * 512 + vs * 32;
        f32x4 T[2][2];
#pragma unroll
        for (int a = 0; a < 2; ++a)
#pragma unroll
            for (int c = 0; c < 2; ++c) T[a][c] = (f32x4){0.f, 0.f, 0.f, 0.f};
        u32x4 kreg[8], vreg, qf[8];
#pragma unroll
        for (int i = 0; i < 8; ++i) { const int pc = F.tid + 512 * i, r = pc >> 5, c16 = pc & 31; kreg[i] = *(const u32x4*)(kb + (size_t)r * RET_N + c16 * 8); }
        { const int r = F.tid >> 2, c16 = F.tid & 3; vreg = *(const u32x4*)(vb + (size_t)r * RET_N + c16 * 8); }
#pragma unroll
        for (int ks = 0; ks < 8; ++ks) qf[ks] = *(const u32x4*)(qb + (size_t)(16 * w + l15) * RET_N + 32 * ks + 8 * g);
        for (int n = 0; n < 32; ++n) {
#pragma unroll
            for (int i = 0; i < 8; ++i) { const int pc = F.tid + 512 * i, r = pc >> 5, c16 = pc & 31; *(LAS u32x4*)(F.lds + R_KS + r * RK_STR + c16 * 16) = kreg[i]; }
            { const int r = F.tid >> 2, c16 = F.tid & 3; *(LAS u32x4*)(F.lds + R_VS + r * RV_STR + c16 * 16) = vreg; }
#pragma unroll
            for (int a = 0; a < 2; ++a)
#pragma unroll
                for (int c = 0; c < 2; ++c) { T[a][c] = T[a][c] * g128;
                    u32x2 wv; wv.x = pk2(T[a][c][0], T[a][c][1]); wv.y = pk2(T[a][c][2], T[a][c][3]);
                    *(LAS u32x2*)(F.lds + R_ST + (16 * c + l15) * RK_STR + (32 * w + 16 * a + 4 * g) * 2) = wv; }
            bf16x8 qc[8];
#pragma unroll
            for (int ks = 0; ks < 8; ++ks) qc[ks] = __builtin_bit_cast(bf16x8, qf[ks]);
            __syncthreads();
            { const int nn = (n + 1 < 32) ? n + 1 : n; const size_t ro0 = (size_t)(128 * nn) * RET_N;
#pragma unroll
              for (int i = 0; i < 8; ++i) { const int pc = F.tid + 512 * i, r = pc >> 5, c16 = pc & 31; kreg[i] = *(const u32x4*)(kb + ro0 + (size_t)r * RET_N + c16 * 8); }
              { const int r = F.tid >> 2, c16 = F.tid & 3; vreg = *(const u32x4*)(vb + ro0 + (size_t)r * RET_N + c16 * 8); }
#pragma unroll
              for (int ks = 0; ks < 8; ++ks) qf[ks] = *(const u32x4*)(qb + ro0 + (size_t)(16 * w + l15) * RET_N + 32 * ks + 8 * g); }
            f32x4 Pt[8];
#pragma unroll
            for (int jt = 0; jt < 8; ++jt) { Pt[jt] = (f32x4){0.f, 0.f, 0.f, 0.f};
                if (jt <= w) {
#pragma unroll
                    for (int ks = 0; ks < 8; ++ks) { const bf16x8 kf = *(const LAS bf16x8*)(F.lds + R_KS + (16 * jt + l15) * RK_STR + (32 * ks + 8 * g) * 2);
                        Pt[jt] = __builtin_amdgcn_mfma_f32_16x16x32_bf16(kf, qc[ks], Pt[jt], 0, 0, 0); }
                    if (jt == w) {
#pragma unroll
                        for (int r = 0; r < 4; ++r) if (4 * g + r > l15) Pt[jt][r] = 0.f; }
                } }
            f32x4 O[2];
#pragma unroll
            for (int vt = 0; vt < 2; ++vt) { O[vt] = (f32x4){0.f, 0.f, 0.f, 0.f};
#pragma unroll
                for (int ks = 0; ks < 8; ++ks) { const bf16x8 sf = *(const LAS bf16x8*)(F.lds + R_ST + (16 * vt + l15) * RK_STR + (32 * ks + 8 * g) * 2);
                    O[vt] = __builtin_amdgcn_mfma_f32_16x16x32_bf16(sf, qc[ks], O[vt], 0, 0, 0); } }
#pragma unroll
            for (int kk = 0; kk < 4; ++kk) {
                if (2 * kk <= w) {
                    const unsigned va = ldsb + R_VS + (32 * kk + 4 * g + q) * RV_STR + 4 * p * 2;
                    bf16x8 v0, v1; ds_tr4(va, va + 16 * RV_STR, va + 32, va + 16 * RV_STR + 32, v0, v1);
                    const bf16x8 pf = pack8(Pt[2 * kk], Pt[2 * kk + 1]);
                    O[0] = __builtin_amdgcn_mfma_f32_16x16x32_bf16(v0, pf, O[0], 0, 0, 0);
                    O[1] = __builtin_amdgcn_mfma_f32_16x16x32_bf16(v1, pf, O[1], 0, 0, 0);
                } }
            { bf16_t* orow = ob + (size_t)(128 * n + 16 * w + l15) * 4096;
#pragma unroll
              for (int vt = 0; vt < 2; ++vt) { u32x2 wv; wv.x = pk2(O[vt][0], O[vt][1]); wv.y = pk2(O[vt][2], O[vt][3]); *(u32x2*)(orow + 16 * vt + 4 * g) = wv; } }
#pragma unroll
            for (int kk = 0; kk < 4; ++kk) {
                const unsigned va = ldsb + R_VS + (32 * kk + 4 * g + q) * RV_STR + 4 * p * 2;
                const unsigned ka = ldsb + R_KS + (32 * kk + 4 * g + q) * RK_STR + (32 * w + 4 * p) * 2;
                bf16x8 v0, v1, k0, k1; ds_tr4(va, va + 16 * RV_STR, va + 32, va + 16 * RV_STR + 32, v0, v1);
                ds_tr4(ka, ka + 16 * RK_STR, ka + 32, ka + 16 * RK_STR + 32, k0, k1);
                T[0][0] = __builtin_amdgcn_mfma_f32_16x16x32_bf16(k0, v0, T[0][0], 0, 0, 0); T[0][1] = __builtin_amdgcn_mfma_f32_16x16x32_bf16(k0, v1, T[0][1], 0, 0, 0);
                T[1][0] = __builtin_amdgcn_mfma_f32_16x16x32_bf16(k1, v0, T[1][0], 0, 0, 0); T[1][1] = __builtin_amdgcn_mfma_f32_16x16x32_bf16(k1, v1, T[1][1], 0, 0, 0);
            }
            __syncthreads();
        }
    }
}

__device__ __forceinline__ void ret_gate_phase(const Frame& F0, const bf16_t* ro, const bf16_t* hp, const float* gng, const float* gnb, bf16_t* gt) {
    const Frame F = relaunder(F0);
    const int gw = F.vcu * 8 + F.wave, NGW = F.G * 8;
    for (int it = gw; it < M * 8; it += NGW) {
        const int row = it >> 3, hd = it & 7, c0 = hd * 512 + F.lane * 8;
        const u32x4 ov = *(const u32x4*)(ro + (size_t)row * 4096 + c0);
        const u32x4 gv = *(const u32x4*)(hp + (size_t)row * RET_N + 4 * D + c0);
        float o[8] = {bflo(ov.x), bfhi(ov.x), bflo(ov.y), bfhi(ov.y), bflo(ov.z), bfhi(ov.z), bflo(ov.w), bfhi(ov.w)};
        const float gg[8] = {bflo(gv.x), bfhi(gv.x), bflo(gv.y), bfhi(gv.y), bflo(gv.z), bfhi(gv.z), bflo(gv.w), bfhi(gv.w)};
        float s = 0.f;
#pragma unroll
        for (int e = 0; e < 8; ++e) s += o[e];
        const float mu = wave_sum(s) * (1.0f / 512.0f);
        float s2 = 0.f;
#pragma unroll
        for (int e = 0; e < 8; ++e) { o[e] -= mu; s2 += o[e] * o[e]; }
        const float rstd = 1.0f / sqrtf(wave_sum(s2) * (1.0f / 512.0f) + EPS);
        const f32x4 ga = *(const f32x4*)(gng + c0), gb = *(const f32x4*)(gng + c0 + 4), ba = *(const f32x4*)(gnb + c0), bb = *(const f32x4*)(gnb + c0 + 4);
        const float gn[8] = {ga[0], ga[1], ga[2], ga[3], gb[0], gb[1], gb[2], gb[3]}, bn[8] = {ba[0], ba[1], ba[2], ba[3], bb[0], bb[1], bb[2], bb[3]};
        float y[8];
#pragma unroll
        for (int e = 0; e < 8; ++e) y[e] = fast_silu(gg[e]) * (o[e] * rstd * gn[e] + bn[e]);
        u32x4 wv; wv.x = pk2(y[0], y[1]); wv.y = pk2(y[2], y[3]); wv.z = pk2(y[4], y[5]); wv.w = pk2(y[6], y[7]);
        *(u32x4*)(gt + (size_t)row * 4096 + c0) = wv;
    }
}

constexpr int SA_STR = 144;
constexpr int SA_KB = 0, SA_VB = 256 * SA_STR, SA_END = SA_VB + 272 * SA_STR;
static_assert(SA_END <= RING_BYTES, "swa LDS");
__device__ __forceinline__ void swa_attn_phase(const Frame& F0, const bf16_t* qkv, const float* sinks, bf16_t* ao) {
    const Frame F = relaunder(F0);
    const int w = F.wave, lane = F.lane, l15 = lane & 15, g = lane >> 4, q = (lane & 15) >> 2, p = lane & 3;
    const unsigned ldsb = (unsigned)(size_t)F.lds;
    for (int item = F.vcu; item < 256; item += F.G) {
        const int b = item >> 7, kvh = (item >> 5) & 3, nb = item & 31;
        const int hq = kvh * 8 + w;
        const float sink = sinks[hq];
        const int tok0 = b * SEQ + 128 * nb;
        __syncthreads();
#pragma unroll
        for (int i = 0; i < 4; ++i) { const int pc = F.tid + 512 * i, r = pc >> 3, c16 = pc & 7;
            unsigned z_ = 0u; asm volatile("" : "+v"(z_));
            u32x4 kv = (u32x4){z_, z_, z_, z_}, vv = kv;
            if (nb > 0 || r >= 128) { const bf16_t* src = qkv + (size_t)(tok0 - 128 + r) * SWA_N + 2048 + kvh * 64 + c16 * 8; kv = *(const u32x4*)src; vv = *(const u32x4*)(src + 256); }
            *(LAS u32x4*)(F.lds + SA_KB + r * SA_STR + c16 * 16) = kv; *(LAS u32x4*)(F.lds + SA_VB + r * SA_STR + c16 * 16) = vv; }
        if (F.tid < 128) { const int r = 256 + (F.tid >> 3), c16 = F.tid & 7; unsigned z_ = 0u; asm volatile("" : "+v"(z_)); *(LAS u32x4*)(F.lds + SA_VB + r * SA_STR + c16 * 16) = (u32x4){z_, z_, z_, z_}; }
        __syncthreads();
        for (int it = 0; it < 8; ++it) {
            const int row = tok0 + 16 * it + l15;
            bf16x8 qf[2];
#pragma unroll
            for (int ks = 0; ks < 2; ++ks) qf[ks] = __builtin_bit_cast(bf16x8, *(const u32x4*)(qkv + (size_t)row * SWA_N + hq * 64 + 32 * ks + 8 * g));
            f32x4 P[10];
            float mx = sink;
#pragma unroll
            for (int t = 0; t < 9; ++t) { const int jt = it + t; P[t] = (f32x4){0.f, 0.f, 0.f, 0.f};
#pragma unroll
                for (int ks = 0; ks < 2; ++ks) { const bf16x8 kf = *(const LAS bf16x8*)(F.lds + SA_KB + (16 * jt + l15) * SA_STR + (32 * ks + 8 * g) * 2);
                    P[t] = __builtin_amdgcn_mfma_f32_16x16x32_bf16(kf, qf[ks], P[t], 0, 0, 0); }
#pragma unroll
                for (int r = 0; r < 4; ++r) { const int jb = 16 * jt + 4 * g + r, diff = 16 * it + l15 + 128 - jb;
                    const bool ok = (diff >= 0) && (diff < 128) && (nb > 0 || jb >= 128);
                    const float sv = ok ? P[t][r] * 0.125f : -1e30f; P[t][r] = sv; mx = fmaxf(mx, sv); } }
            mx = fmaxf(mx, __shfl_xor(mx, 16)); mx = fmaxf(mx, __shfl_xor(mx, 32));
            float den = 0.f;
#pragma unroll
            for (int t = 0; t < 9; ++t)
#pragma unroll
                for (int r = 0; r < 4; ++r) { const float e = (P[t][r] > -1e29f) ? __builtin_amdgcn_exp2f((P[t][r] - mx) * 1.44269504089f) : 0.f; P[t][r] = e; den += e; }
            P[9] = (f32x4){0.f, 0.f, 0.f, 0.f};
            den += __shfl_xor(den, 16); den += __shfl_xor(den, 32);
            den += __builtin_amdgcn_exp2f((sink - mx) * 1.44269504089f);
            const float rden = 1.0f / den;
            f32x4 O[4];
#pragma unroll
            for (int dt = 0; dt < 4; ++dt) O[dt] = (f32x4){0.f, 0.f, 0.f, 0.f};
#pragma unroll
            for (int kk = 0; kk < 5; ++kk) {
                const bf16x8 pf = pack8(P[2 * kk], P[2 * kk + 1]);
                const unsigned va = ldsb + SA_VB + (16 * (it + 2 * kk) + 4 * g + q) * SA_STR + 4 * p * 2;
                bf16x8 v0, v1, v2, v3; ds_tr4(va, va + 16 * SA_STR, va + 32, va + 16 * SA_STR + 32, v0, v1); ds_tr4(va + 64, va + 16 * SA_STR + 64, va + 96, va + 16 * SA_STR + 96, v2, v3);
                O[0] = __builtin_amdgcn_mfma_f32_16x16x32_bf16(v0, pf, O[0], 0, 0, 0); O[1] = __builtin_amdgcn_mfma_f32_16x16x32_bf16(v1, pf, O[1], 0, 0, 0);
                O[2] = __builtin_amdgcn_mfma_f32_16x16x32_bf16(v2, pf, O[2], 0, 0, 0); O[3] = __builtin_amdgcn_mfma_f32_16x16x32_bf16(v3, pf, O[3], 0, 0, 0);
            }
            bf16_t* orow = ao + (size_t)row * D + hq * 64;
#pragma unroll
            for (int dt = 0; dt < 4; ++dt) { u32x2 wv; wv.x = pk2(O[dt][0] * rden, O[dt][1] * rden); wv.y = pk2(O[dt][2] * rden, O[dt][3] * rden); *(u32x2*)(orow + 16 * dt + 4 * g) = wv; }
        }
    }
}

constexpr int NPH = 61;
struct Args { const void* in[18]; float* out; unsigned char* ws; int ph_lo, ph_hi; };
typedef const Args __attribute__((address_space(4)))* KArgs;
__device__ __forceinline__ KArgs kargs() { KArgs p = (KArgs)__builtin_amdgcn_kernarg_segment_ptr(); asm volatile("" : "+s"(p)); return p; }
#define KIN(T, i) ((const T*)ka->in[i])
#define KWS(T, off) ((T*)(ka->ws + (off)))

__global__ void __launch_bounds__(512, 2) mk_fwd(Args args) {
    extern __shared__ __attribute__((aligned(16))) unsigned char lds_raw[];
    Frame F;
    F.lds = (LAS unsigned char*)lds_raw;
    F.tid = threadIdx.x; F.lane = F.tid & 63; F.wave = __builtin_amdgcn_readfirstlane(F.tid >> 6);
    F.G = gridDim.x; { const int bx = blockIdx.x; F.vcu = (F.G % 8 == 0) ? (bx % 8) * (F.G / 8) + bx / 8 : bx; }
    volatile LAS unsigned* MISC = (volatile LAS unsigned*)(F.lds + MISC_OFF);
    for (int u = F.tid; u < (LDS_BYTES - RING_BYTES) / 4; u += 512) ((LAS unsigned*)(F.lds + RING_BYTES))[u] = 0u;
    __syncthreads();
    const int lo = args.ph_lo, hi = args.ph_hi;
    XcdBarrier bar; bar.bar = (unsigned*)(args.ws + WS_CTL) + CW_BAR; bar.x = 0; bar.st = nullptr;
    if (hi - lo > 1) bar = xcd_barrier_post((unsigned*)(args.ws + WS_CTL) + CW_BAR, MISC + 8);
#define IN(k) (lo <= (k) && (k) < hi)
#define ENDP(k) do { if ((k) + 1 < hi) { XcdBarrier bb_ = bar; asm volatile("" : "+s"(bb_.bar)); xcd_barrier(bb_); } } while (0)

    if (IN(0)) {
        { KArgs ka = kargs(); convert_stack(F, KIN(float, 5), KWS(bf16_t, WS_WFFIN), 8, D, 2 * DFF, 1); }
        { KArgs ka = kargs(); convert_stack(F, KIN(float, 6), KWS(bf16_t, WS_WFFOUT), 8, DFF, D, 0); }
        { KArgs ka = kargs(); convert_stack(F, KIN(float, 7), KWS(bf16_t, WS_WPOOL), 8, 512, 512, 0); }
        { KArgs ka = kargs(); convert_stack(F, KIN(float, 9), KWS(bf16_t, WS_WRIN), 1, D, RET_N, 0); }
        { KArgs ka = kargs(); convert_stack(F, KIN(float, 12), KWS(bf16_t, WS_WROUT), 1, 2 * D, D, 0); }
        { KArgs ka = kargs(); convert_stack(F, KIN(float, 13), KWS(bf16_t, WS_WSIN), 1, D, SWA_N, 2); }
        { KArgs ka = kargs(); convert_stack(F, KIN(float, 16), KWS(bf16_t, WS_WSOUT), 1, D, D, 0); }
        { KArgs ka = kargs(); rope_tables(F, KIN(int, 1), KWS(float, WS_RCOS), KWS(float, WS_RSIN), KWS(float, WS_SCOS), KWS(float, WS_SSIN)); }
        { KArgs ka = kargs(); norm_phase(F, KIN(float, 0), nullptr, nullptr, 0.f, nullptr, KIN(float, 2), KWS(bf16_t, WS_U)); }
        ENDP(0);
    }

#pragma nounroll
    for (int L = 0; L < DEPTH; ++L) {
        const int pb = 1 + 16 * L, kind = L % 3;
#pragma nounroll
        for (int sub = 0; sub < 2; ++sub) {
            const int pf = pb + 9 * sub, wi = 2 * L + sub;
            if (IN(pf)) {
                KArgs ka = kargs();
                pg8::Gemm gm{KWS(bf16_t, WS_U), KWS(bf16_t, WS_WFFIN + (size_t)wi * W_FFIN_SZ), M, 2 * DFF, D, D, D};
                pg8::StaticOrder S; S.init(M, 2 * DFF, F.G, (int)blockIdx.x);
                pg8::EpiSwiglu E{KWS(bf16_t, WS_BIG), DFF};
                pg8::gemm_phase<pg8::EpiSwiglu, pg8::StaticOrder>(F.lds, gm, S, E);
                ENDP(pf);
            }
            if (IN(pf + 1)) {
                KArgs ka = kargs();
                pg8::Gemm gm{KWS(bf16_t, WS_BIG), KWS(bf16_t, WS_WFFOUT + (size_t)wi * W_FFOUT_SZ), M, D, DFF, DFF, DFF};
                pg8::StaticOrder S; S.init(M, D, F.G, (int)blockIdx.x);
                pg8::EpiF32 E{KWS(float, WS_F), D, nullptr, nullptr};
                pg8::gemm_phase<pg8::EpiF32, pg8::StaticOrder>(F.lds, gm, S, E);
                ENDP(pf + 1);
            }
            if (IN(pf + 2)) {
                KArgs ka = kargs();
                const float* gpost = (sub == 0 ? KIN(float, 2) : KIN(float, 4)) + (size_t)(L * 2 + 1) * D;
                const float* gnext = (sub == 0) ? KIN(float, 3) + (size_t)(L * 2) * D : (L + 1 < DEPTH ? KIN(float, 2) + (size_t)((L + 1) * 2) * D : nullptr);
                const float* hin = (L == 0 && sub == 0) ? KIN(float, 0) : KWS(float, WS_H);
                float* hout = (L + 1 == DEPTH && sub == 1) ? ka->out : KWS(float, WS_H);
                norm_phase(F, hin, hout, KWS(float, WS_F), 0.5f, gpost, gnext, KWS(bf16_t, WS_U));
                ENDP(pf + 2);
            }
            if (sub == 0) {
                const int pm = pb + 3;
                if (kind == 0) {
                    if (IN(pm)) { KArgs ka = kargs(); pool_phase(F, KWS(bf16_t, WS_U), KWS(bf16_t, WS_X2)); ENDP(pm); }
                } else if (kind == 1) {
                    if (IN(pm)) {
                        KArgs ka = kargs();
                        pg8::Gemm gm{KWS(bf16_t, WS_U), KWS(bf16_t, WS_WRIN), M, RET_N, D, D, D};
                        pg8::StaticOrder S; S.init(M, RET_N, F.G, (int)blockIdx.x);
                        pg8::EpiRetIn E{KWS(bf16_t, WS_BIG), KWS(float, WS_RCOS), KWS(float, WS_RSIN)};
                        pg8::gemm_phase<pg8::EpiRetIn, pg8::StaticOrder>(F.lds, gm, S, E);
                        ENDP(pm);
                    }
                    if (IN(pm + 1)) { KArgs ka = kargs(); ret_core_phase(F, KWS(bf16_t, WS_BIG), KWS(bf16_t, WS_RO)); ENDP(pm + 1); }
                    if (IN(pm + 2)) { KArgs ka = kargs(); ret_gate_phase(F, KWS(bf16_t, WS_RO), KWS(bf16_t, WS_BIG), KIN(float, 10), KIN(float, 11), KWS(bf16_t, WS_GT)); ENDP(pm + 2); }
                } else {
                    if (IN(pm)) {
                        KArgs ka = kargs();
                        pg8::Gemm gm{KWS(bf16_t, WS_U), KWS(bf16_t, WS_WSIN), M, SWA_N, D, D, D};
                        pg8::StaticOrder S; S.init(M, SWA_N, F.G, (int)blockIdx.x);
                        pg8::EpiSwaIn E{KWS(bf16_t, WS_BIG), KIN(float, 14), KWS(float, WS_SCOS), KWS(float, WS_SSIN)};
                        pg8::gemm_phase<pg8::EpiSwaIn, pg8::StaticOrder>(F.lds, gm, S, E);
                        ENDP(pm);
                    }
                    if (IN(pm + 1)) { KArgs ka = kargs(); swa_attn_phase(F, KWS(bf16_t, WS_BIG), KIN(float, 15), KWS(bf16_t, WS_X2)); ENDP(pm + 1); }
                }
                if (IN(pb + 7)) {
                    KArgs ka = kargs();
                    const int jm = L / 3;
                    pg8::Gemm gm; pg8::StaticOrder S; pg8::EpiF32 E{KWS(float, WS_F), D, nullptr, nullptr};
                    if (kind == 0) { gm = pg8::Gemm{KWS(bf16_t, WS_X2), KWS(bf16_t, WS_WPOOL + (size_t)jm * D * 512 * 2), M, D, 512, D, 512}; S.init(M, D, F.G, (int)blockIdx.x, 512); E.scale = KIN(float, 8) + (size_t)jm * D; }
                    else if (kind == 1) { gm = pg8::Gemm{KWS(bf16_t, WS_GT), KWS(bf16_t, WS_WROUT), M, D, 2 * D, 2 * D, 2 * D}; S.init(M, D, F.G, (int)blockIdx.x); }
                    else { gm = pg8::Gemm{KWS(bf16_t, WS_X2), KWS(bf16_t, WS_WSOUT), M, D, D, D, D}; S.init(M, D, F.G, (int)blockIdx.x); E.bias = KIN(float, 17); }
                    pg8::gemm_phase<pg8::EpiF32, pg8::StaticOrder>(F.lds, gm, S, E);
                    ENDP(pb + 7);
                }
                if (IN(pb + 8)) {
                    KArgs ka = kargs();
                    norm_phase(F, KWS(float, WS_H), KWS(float, WS_H), KWS(float, WS_F), 1.0f, KIN(float, 3) + (size_t)(L * 2 + 1) * D, KIN(float, 4) + (size_t)(L * 2) * D, KWS(bf16_t, WS_U));
                    ENDP(pb + 8);
                }
            }
        }
    }
#undef IN
#undef ENDP
}

static bool phase_exists(int p) {
    if (p == 0) return true;
    const int L = (p - 1) / 16, s = (p - 1) % 16, kind = L % 3;
    if (s <= 2 || (s >= 7 && s <= 11)) return true;
    if (s == 3) return true;
    if (s == 4) return kind != 0;
    if (s == 5) return kind == 1;
    return false;
}
extern "C" void kernel_launch(void* const* d_in, const int* in_sizes, int n_in, void* d_out, int out_size, void* d_ws, size_t ws_size, hipStream_t stream) {
    static int grid = 0;
    if (grid == 0) {
        if (n_in != 18 || in_sizes[0] != M * D || out_size != M * D || ws_size < WS_END) { fprintf(stderr, "kernel_launch: unexpected problem (n_in %d, in0 %d, out %d, ws %zu, need %zu)\n", n_in, n_in > 0 ? in_sizes[0] : -1, out_size, ws_size, (size_t)WS_END); grid = -1; return; }
        int dev = 0, cus = 0, per_cu = 0;
        if (hipGetDevice(&dev) != hipSuccess || hipDeviceGetAttribute(&cus, hipDeviceAttributeMultiprocessorCount, dev) != hipSuccess) { grid = -1; return; }
        if (hipFuncSetAttribute((const void*)mk_fwd, hipFuncAttributeMaxDynamicSharedMemorySize, LDS_BYTES) != hipSuccess) { fprintf(stderr, "kernel_launch: hipFuncSetAttribute failed\n"); grid = -1; return; }
        if (hipOccupancyMaxActiveBlocksPerMultiprocessor(&per_cu, (const void*)mk_fwd, 512, LDS_BYTES) != hipSuccess || per_cu < 1) fprintf(stderr, "kernel_launch: occupancy query says %d blocks per CU\n", per_cu);
        (void)hipGetLastError();
        grid = cus;
    }
    if (grid < 0) return;
    if (hipMemsetAsync((char*)d_ws + WS_CTL, 0, CTL_ZERO_BYTES, stream) != hipSuccess) return;
    Args a{};
    for (int i = 0; i < 18; ++i) a.in[i] = d_in[i];
    a.out = (float*)d_out; a.ws = (unsigned char*)d_ws;
#if MK_MEGA
    a.ph_lo = 0; a.ph_hi = NPH;
    hipLaunchKernelGGL(mk_fwd, dim3(grid), dim3(512), LDS_BYTES, stream, a);
#else
    for (int p = 0; p < NPH; ++p) { if (!phase_exists(p)) continue; a.ph_lo = p; a.ph_hi = p + 1; hipLaunchKernelGGL(mk_fwd, dim3(grid), dim3(512), LDS_BYTES, stream, a); }
#endif
}
```

```cpp
#include <hip/hip_runtime.h>
#include <cstdio>
#include <cstdint>

#ifndef MK_MEGA
#define MK_MEGA 1
#endif

#define LAS __attribute__((address_space(3)))
#define GAS __attribute__((address_space(1)))
typedef unsigned short bf16_t;
typedef short bf16x8 __attribute__((ext_vector_type(8)));
typedef short bf16x4 __attribute__((ext_vector_type(4)));
typedef float f32x4 __attribute__((ext_vector_type(4)));
typedef float f32x2 __attribute__((ext_vector_type(2)));
typedef unsigned u32x4 __attribute__((ext_vector_type(4)));
typedef unsigned u32x2 __attribute__((ext_vector_type(2)));

constexpr int D = 2048, SEQ = 4096, NB = 2, M = NB * SEQ, DFF = 5504, DEPTH = 4;
constexpr float EPS = 1e-6f;
constexpr int RET_N = 6 * D;
constexpr int SWA_N = 2560;

__device__ __forceinline__ unsigned f2bf(float f) { unsigned u = __builtin_bit_cast(unsigned, f); return (u + 0x7fffu + ((u >> 16) & 1u)) >> 16; }
__device__ __forceinline__ unsigned pk2(float lo, float hi) { return f2bf(lo) | (f2bf(hi) << 16); }
__device__ __forceinline__ float bf2f(unsigned short b) { return __builtin_bit_cast(float, (unsigned)b << 16); }
__device__ __forceinline__ float bflo(unsigned w) { return __builtin_bit_cast(float, w << 16); }
__device__ __forceinline__ float bfhi(unsigned w) { return __builtin_bit_cast(float, w & 0xffff0000u); }
__device__ __forceinline__ float wave_sum(float v) {
#pragma unroll
    for (int o = 1; o < 64; o <<= 1) v += __shfl_xor(v, o);
    return v;
}
__device__ __forceinline__ float log2_gamma(int hd) { const float e = ldexpf(1.0f, -5 - hd); float p = 1.0f / 7.0f; p = p * e + 1.0f / 6.0f; p = p * e + 0.2f; p = p * e + 0.25f; p = p * e + 1.0f / 3.0f; p = p * e + 0.5f; p = p * e + 1.0f; return -1.44269504089f * e * p; }
__device__ __forceinline__ float fast_silu(float x) { return x * __builtin_amdgcn_rcpf(1.0f + __builtin_amdgcn_exp2f(-1.44269504089f * x)); }

namespace pg8 {
constexpr int BM = 256, BK = 64, HALF = 128, HTB = HALF * BK * 2, STAGE_BYTES = 8 * HTB, NXCD = 8, WGM = 8;
__host__ __device__ __forceinline__ int lds_byte(int r, int c) { const int st = (r >> 4) * 2 + (c >> 5), rr = r & 15, cc = c & 31, ob = rr * 64 + cc * 2; return st * 1024 + (ob ^ (((ob >> 9) & 1) << 5)); }
__host__ __device__ __forceinline__ void stage_rc(int b, int& R, int& C) { const int st = b / 1024, sb = b % 1024, swz = sb ^ (((sb >> 9) & 1) << 5); R = (st >> 1) * 16 + swz / 64; C = (st & 1) * 32 + (swz % 64) / 2; }
__host__ __device__ __forceinline__ int perm32(int rho) { const int n = rho >> 4, i = rho & 15; return 8 * (i >> 2) + 4 * n + (i & 3); }

struct Unit { int pm, pn, ka; };
struct Gemm { const bf16_t* A; const bf16_t* Bt; int M, N, K, lda, ldb; };

struct StaticOrder {
    int nM, nN, nwg, G, c, kgrp;
    __host__ __device__ void init(int M_, int N_, int G_, int c_, int kgrp_ = 0) { nM = M_ / BM; nN = N_ / BM; nwg = nM * nN; G = G_; c = c_; kgrp = kgrp_; }
    __host__ __device__ bool next(int i, Unit& u) const {
        const long L = (long)i * G + c; if (L >= nwg) return false;
        int wgid = (int)L; { const int q = nwg / NXCD, r = nwg % NXCD, xcd = wgid % NXCD, off = wgid / NXCD; wgid = (xcd < r ? xcd * (q + 1) : r * (q + 1) + (xcd - r) * q) + off; }
        const int nig = WGM * nN, gid = wgid / nig, fm = gid * WGM, gsz = (nM - fm) < WGM ? (nM - fm) : WGM;
        u.pm = fm + ((wgid % nig) % gsz); u.pn = (wgid % nig) / gsz; u.ka = kgrp ? (u.pn >> 1) * kgrp : 0; return true;
    }
    __device__ __forceinline__ void a_ready(const Unit&) const {}
    __device__ __forceinline__ void done(const Unit&) const {}
};

struct EpiF32 {
    static constexpr bool PERM = false;
    float* C; int ldc; const float* bias; const float* scale;
    __device__ __forceinline__ void operator()(const f32x4 (&acc)[2][2][4][2], const Unit& u, int wr, int wc, int fr, int fq) const {
        const int row0 = u.pm * BM + wr * 64 + fr, col0 = u.pn * BM + wc * 32 + 4 * fq;
        f32x4 bv[2][2], sv[2][2];
#pragma unroll
        for (int bj = 0; bj < 2; ++bj)
#pragma unroll
            for (int n = 0; n < 2; ++n) { bv[bj][n] = bias ? *(const f32x4*)(bias + col0 + bj * HALF + n * 16) : (f32x4){0.f, 0.f, 0.f, 0.f};
                                          sv[bj][n] = scale ? *(const f32x4*)(scale + col0 + bj * HALF + n * 16) : (f32x4){1.f, 1.f, 1.f, 1.f}; }
#pragma unroll
        for (int ai = 0; ai < 2; ++ai)
#pragma unroll
            for (int m = 0; m < 4; ++m) { float* rowp = C + (size_t)(row0 + ai * HALF + m * 16) * ldc + col0;
#pragma unroll
                for (int bj = 0; bj < 2; ++bj)
#pragma unroll
                    for (int n = 0; n < 2; ++n) *(f32x4*)(rowp + bj * HALF + n * 16) = (acc[ai][bj][m][n] + bv[bj][n]) * sv[bj][n]; }
    }
};
struct EpiSwiglu {
    static constexpr bool PERM = true;
    bf16_t* O; int ldc;
    __device__ __forceinline__ void operator()(const f32x4 (&acc)[2][2][4][2], const Unit& u, int wr, int wc, int fr, int fq) const {
        const int row0 = u.pm * BM + wr * 64 + fr, col0 = u.pn * HALF + wc * 32 + 8 * fq;
#pragma unroll
        for (int ai = 0; ai < 2; ++ai)
#pragma unroll
            for (int m = 0; m < 4; ++m) {
                const f32x4 g0 = acc[ai][0][m][0], g1 = acc[ai][0][m][1], u0 = acc[ai][1][m][0], u1 = acc[ai][1][m][1];
                u32x4 w;
                w.x = pk2(fast_silu(g0[0]) * u0[0], fast_silu(g0[1]) * u0[1]); w.y = pk2(fast_silu(g0[2]) * u0[2], fast_silu(g0[3]) * u0[3]);
                w.z = pk2(fast_silu(g1[0]) * u1[0], fast_silu(g1[1]) * u1[1]); w.w = pk2(fast_silu(g1[2]) * u1[2], fast_silu(g1[3]) * u1[3]);
                *(u32x4*)(O + (size_t)(row0 + ai * HALF + m * 16) * ldc + col0) = w; }
    }
};
struct EpiRetIn {
    static constexpr bool PERM = true;
    bf16_t* O; const float* cs; const float* sn;
    __device__ __forceinline__ void operator()(const f32x4 (&acc)[2][2][4][2], const Unit& u, int wr, int wc, int fr, int fq) const {
        const int row0 = u.pm * BM + wr * 64 + fr, j0 = wc * 32 + 8 * fq;
        if (u.pn < 16) {
            const int hd = u.pn & 7; const bool isq = u.pn < 8;
            const float l2g = log2_gamma(hd);
#pragma unroll
            for (int ai = 0; ai < 2; ++ai)
#pragma unroll
                for (int m = 0; m < 4; ++m) { const int row = row0 + ai * HALF + m * 16; const int ic = row & 127;
                    const float dsc = isq ? __builtin_amdgcn_exp2f(l2g * (float)ic) : 0.0625f * __builtin_amdgcn_exp2f(-l2g * (float)ic);
                    const f32x4 c0 = *(const f32x4*)(cs + (size_t)row * 128 + j0), c1 = *(const f32x4*)(cs + (size_t)row * 128 + j0 + 4);
                    const f32x4 s0 = *(const f32x4*)(sn + (size_t)row * 128 + j0), s1 = *(const f32x4*)(sn + (size_t)row * 128 + j0 + 4);
                    const f32x4 a0 = acc[ai][0][m][0], a1 = acc[ai][0][m][1], b0 = acc[ai][1][m][0], b1 = acc[ai][1][m][1];
                    const f32x4 x0 = (a0 * c0 - b0 * s0) * dsc, x1 = (a1 * c1 - b1 * s1) * dsc, y0 = (b0 * c0 + a0 * s0) * dsc, y1 = (b1 * c1 + a1 * s1) * dsc;
                    u32x4 w0, w1; w0.x = pk2(x0[0], x0[1]); w0.y = pk2(x0[2], x0[3]); w0.z = pk2(x1[0], x1[1]); w0.w = pk2(x1[2], x1[3]);
                    w1.x = pk2(y0[0], y0[1]); w1.y = pk2(y0[2], y0[3]); w1.z = pk2(y1[0], y1[1]); w1.w = pk2(y1[2], y1[3]);
                    bf16_t* rowp = O + (size_t)row * RET_N + u.pn * BM + j0;
                    *(u32x4*)(rowp) = w0; *(u32x4*)(rowp + HALF) = w1; }
        } else {
#pragma unroll
            for (int ai = 0; ai < 2; ++ai)
#pragma unroll
                for (int m = 0; m < 4; ++m) { bf16_t* rowp = O + (size_t)(row0 + ai * HALF + m * 16) * RET_N + u.pn * BM + j0;
#pragma unroll
                    for (int bj = 0; bj < 2; ++bj) { const f32x4 v0 = acc[ai][bj][m][0], v1 = acc[ai][bj][m][1];
                        u32x4 w; w.x = pk2(v0[0], v0[1]); w.y = pk2(v0[2], v0[3]); w.z = pk2(v1[0], v1[1]); w.w = pk2(v1[2], v1[3]);
                        *(u32x4*)(rowp + bj * HALF) = w; } }
        }
    }
};
struct EpiSwaIn {
    static constexpr bool PERM = true;
    bf16_t* O; const float* bias; const float* cs; const float* sn;
    __device__ __forceinline__ void operator()(const f32x4 (&acc)[2][2][4][2], const Unit& u, int wr, int wc, int fr, int fq) const {
        const int row0 = u.pm * BM + wr * 64 + fr, j0 = 8 * fq, cbase = u.pn * BM + 64 * wc;
        const f32x4 ba0 = *(const f32x4*)(bias + cbase + j0), ba1 = *(const f32x4*)(bias + cbase + j0 + 4), bb0 = *(const f32x4*)(bias + cbase + 32 + j0), bb1 = *(const f32x4*)(bias + cbase + 32 + j0 + 4);
        const bool rot = u.pn < 9;
#pragma unroll
        for (int ai = 0; ai < 2; ++ai)
#pragma unroll
            for (int m = 0; m < 4; ++m) { const int row = row0 + ai * HALF + m * 16;
                f32x4 c0 = (f32x4){1.f, 1.f, 1.f, 1.f}, c1 = c0, s0 = (f32x4){0.f, 0.f, 0.f, 0.f}, s1 = s0;
                if (rot) { c0 = *(const f32x4*)(cs + (size_t)row * 32 + j0); c1 = *(const f32x4*)(cs + (size_t)row * 32 + j0 + 4); s0 = *(const f32x4*)(sn + (size_t)row * 32 + j0); s1 = *(const f32x4*)(sn + (size_t)row * 32 + j0 + 4); }
                const f32x4 a0 = acc[ai][0][m][0] + ba0, a1 = acc[ai][0][m][1] + ba1, b0 = acc[ai][1][m][0] + bb0, b1 = acc[ai][1][m][1] + bb1;
                const f32x4 x0 = a0 * c0 - b0 * s0, x1 = a1 * c1 - b1 * s1, y0 = b0 * c0 + a0 * s0, y1 = b1 * c1 + a1 * s1;
                u32x4 w0, w1; w0.x = pk2(x0[0], x0[1]); w0.y = pk2(x0[2], x0[3]); w0.z = pk2(x1[0], x1[1]); w0.w = pk2(x1[2], x1[3]);
                w1.x = pk2(y0[0], y0[1]); w1.y = pk2(y0[2], y0[3]); w1.z = pk2(y1[0], y1[1]); w1.w = pk2(y1[2], y1[3]);
                bf16_t* rowp = O + (size_t)row * SWA_N + cbase + j0;
                *(u32x4*)(rowp) = w0; *(u32x4*)(rowp + 32) = w1; }
    }
};

template <class Epi, class Sched>
__device__ __forceinline__ void gemm_phase(LAS unsigned char* lds, const Gemm g, const Sched& S, const Epi& E) {
    int tid_ = threadIdx.x; asm volatile("" : "+v"(tid_));
    const int tid = tid_, wid = __builtin_amdgcn_readfirstlane(tid >> 6), lane = tid & 63, wr = wid >> 2, wc = wid & 3, fr = lane & 15, fq = lane >> 4;
    const int K = g.K, nt = K / BK;
    unsigned voffA[2], voffB[2];
#pragma unroll
    for (int i = 0; i < 2; ++i) { int R, C; stage_rc(tid * 16 + i * 8192, R, C); const int Rb = Epi::PERM ? ((R & ~31) + perm32(R & 31)) : R;
        voffA[i] = (unsigned)(R * g.lda + C) * 2u; voffB[i] = (unsigned)(Rb * g.ldb + C) * 2u; }
    const size_t kstep = (size_t)(BK * 2);
    const size_t hstepA = (size_t)HALF * g.lda * 2, hstepB = (size_t)HALF * g.ldb * 2;
    const size_t tstepA = 2 * hstepA, tstepB = 2 * hstepB;
    const unsigned ldsw = (unsigned)wid * 1024u;
    const int aoff = lds_byte(wr * 64 + fr, fq * 8), boff = lds_byte(wc * 32 + fr, fq * 8);
#define PG8_SA(b, h) (((b) * 2 + (h)) * HTB)
#define PG8_SB(b, h) ((4 + (b) * 2 + (h)) * HTB)
#define PG8_STAGE(bufoff, gbase, voff) do { _Pragma("unroll") for (int _i = 0; _i < 2; ++_i) \
        __builtin_amdgcn_global_load_lds((const unsigned*)((const char*)(gbase) + (voff)[_i]), (LAS unsigned*)(lds + (bufoff) + ldsw + _i * 8192), 16, 0, 0); } while (0)
#define PG8_LDA(dst, b, h) do { _Pragma("unroll") for (int m = 0; m < 4; ++m) _Pragma("unroll") for (int k = 0; k < 2; ++k) dst[m][k] = *(const LAS bf16x8*)(lds + PG8_SA(b, h) + aoff + m * 2048 + k * 1024); } while (0)
#define PG8_LDB(dst, b, h) do { _Pragma("unroll") for (int n = 0; n < 2; ++n) _Pragma("unroll") for (int k = 0; k < 2; ++k) dst[n][k] = *(const LAS bf16x8*)(lds + PG8_SB(b, h) + boff + n * 2048 + k * 1024); } while (0)
#define PG8_MMA(ai, bj, At, Bt) do { __builtin_amdgcn_s_setprio(1); _Pragma("unroll") for (int m = 0; m < 4; ++m) _Pragma("unroll") for (int n = 0; n < 2; ++n) _Pragma("unroll") for (int k = 0; k < 2; ++k) \
        acc[ai][bj][m][n] = __builtin_amdgcn_mfma_f32_16x16x32_bf16(Bt[n][k], At[m][k], acc[ai][bj][m][n], 0, 0, 0); __builtin_amdgcn_s_setprio(0); } while (0)
#define PG8_WAIT_V(n) asm volatile("s_waitcnt vmcnt(" #n ")" ::: "memory")
#define PG8_WAIT_L(n) asm volatile("s_waitcnt lgkmcnt(" #n ")" ::: "memory")
#define PG8_BAR __builtin_amdgcn_s_barrier()
#define PG8_SCHED __builtin_amdgcn_sched_barrier(0)
    Unit cur, nxt; int ui = 0;
    if (!S.next(0, cur)) return;
    f32x4 acc[2][2][4][2];
#pragma unroll
    for (int a = 0; a < 2; ++a)
#pragma unroll
        for (int b = 0; b < 2; ++b)
#pragma unroll
            for (int m = 0; m < 4; ++m)
#pragma unroll
                for (int n = 0; n < 2; ++n) acc[a][b][m][n] = (f32x4){0.f, 0.f, 0.f, 0.f};
    bf16x8 At[4][2], B0[2][2], B1[2][2];
    const char* cA = (const char*)g.A + (size_t)cur.pm * tstepA + (size_t)cur.ka * 2; const char* cB = (const char*)g.Bt + (size_t)cur.pn * tstepB;
    S.a_ready(cur);
    PG8_STAGE(PG8_SB(0, 0), cB, voffB); PG8_STAGE(PG8_SB(0, 1), cB + hstepB, voffB); PG8_STAGE(PG8_SA(0, 0), cA, voffA); PG8_STAGE(PG8_SA(0, 1), cA + hstepA, voffA);
    if (wr == 1) PG8_BAR;
    PG8_WAIT_V(2); PG8_BAR;
    PG8_STAGE(PG8_SB(1, 0), cB + kstep, voffB); PG8_STAGE(PG8_SA(1, 0), cA + kstep, voffA); PG8_STAGE(PG8_SB(1, 1), cB + hstepB + kstep, voffB);
    PG8_WAIT_V(6); PG8_BAR;
    for (;;) {
        const bool has_next = S.next(ui + 1, nxt);
        const char* nA = has_next ? (const char*)g.A + (size_t)nxt.pm * tstepA + (size_t)nxt.ka * 2 : cA; const char* nB = has_next ? (const char*)g.Bt + (size_t)nxt.pn * tstepB : cB;
        for (int t = 0; t < nt; t += 2) {
            const bool last = (t == nt - 2);
            const char* a1 = cA + (size_t)(t + 1) * kstep;
            const char* a2 = last ? nA : cA + (size_t)(t + 2) * kstep; const char* b2 = last ? nB : cB + (size_t)(t + 2) * kstep;
            const char* a3 = a2 + kstep; const char* b3 = b2 + kstep;
            if (last && has_next) S.a_ready(nxt);
            PG8_LDB(B0, 0, 0); PG8_LDB(B1, 0, 1); PG8_SCHED; PG8_LDA(At, 0, 0); PG8_STAGE(PG8_SA(1, 1), a1 + hstepA, voffA);
            PG8_WAIT_V(8); PG8_WAIT_L(0); PG8_BAR; PG8_MMA(0, 0, At, B0); PG8_MMA(0, 1, At, B1); PG8_BAR; PG8_SCHED;
            PG8_LDA(At, 0, 1); PG8_STAGE(PG8_SB(0, 0), b2, voffB); PG8_STAGE(PG8_SB(0, 1), b2 + hstepB, voffB); PG8_STAGE(PG8_SA(0, 0), a2, voffA);
            PG8_WAIT_V(8); PG8_WAIT_L(0); PG8_BAR; PG8_MMA(1, 0, At, B0); PG8_MMA(1, 1, At, B1); PG8_BAR; PG8_SCHED;
            PG8_LDB(B0, 1, 0); PG8_LDB(B1, 1, 1); PG8_SCHED; PG8_LDA(At, 1, 0); PG8_STAGE(PG8_SA(0, 1), a2 + hstepA, voffA);
            PG8_WAIT_V(8); PG8_WAIT_L(0); PG8_BAR; PG8_MMA(0, 0, At, B0); PG8_MMA(0, 1, At, B1); PG8_BAR; PG8_SCHED;
            PG8_LDA(At, 1, 1); PG8_STAGE(PG8_SB(1, 0), b3, voffB); PG8_STAGE(PG8_SB(1, 1), b3 + hstepB, voffB); PG8_STAGE(PG8_SA(1, 0), a3, voffA);
            PG8_WAIT_V(8); PG8_WAIT_L(0); PG8_BAR; PG8_MMA(1, 0, At, B0); PG8_MMA(1, 1, At, B1); PG8_BAR; PG8_SCHED;
        }
        if (wr == 0) PG8_BAR;
        E(acc, cur, wr, wc, fr, fq); S.done(cur);
        if (!has_next) break;
#pragma unroll
        for (int a = 0; a < 2; ++a)
#pragma unroll
            for (int b = 0; b < 2; ++b)
#pragma unroll
                for (int m = 0; m < 4; ++m)
#pragma unroll
                    for (int n = 0; n < 2; ++n) acc[a][b][m][n] = (f32x4){0.f, 0.f, 0.f, 0.f};
        cur = nxt; cA = nA; cB = nB; ++ui;
        if (wr == 1) PG8_BAR;
    }
    PG8_WAIT_V(0);
    PG8_BAR;
#undef PG8_SA
#undef PG8_SB
#undef PG8_STAGE
#undef PG8_LDA
#undef PG8_LDB
#undef PG8_MMA
#undef PG8_WAIT_V
#undef PG8_WAIT_L
#undef PG8_BAR
#undef PG8_SCHED
}
}

constexpr size_t MiB = 1u << 20;
constexpr size_t WS_CTL = 0, CTL_ZERO_BYTES = 1 * MiB;
constexpr size_t WS_RCOS = 2 * MiB, WS_RSIN = 6 * MiB, WS_SCOS = 10 * MiB, WS_SSIN = 11 * MiB;
constexpr size_t WS_H = 16 * MiB;
constexpr size_t WS_F = 80 * MiB;
constexpr size_t WS_U = 144 * MiB;
constexpr size_t WS_X2 = 176 * MiB;
constexpr size_t WS_BIG = 208 * MiB;
constexpr size_t WS_RO = 400 * MiB;
constexpr size_t WS_GT = 464 * MiB;
constexpr size_t WS_W = 528 * MiB;
constexpr size_t W_FFIN_SZ = (size_t)2 * DFF * D * 2, W_FFOUT_SZ = (size_t)D * DFF * 2;
constexpr size_t WS_WFFIN = WS_W, WS_WFFOUT = WS_WFFIN + 8 * W_FFIN_SZ, WS_WPOOL = WS_WFFOUT + 8 * W_FFOUT_SZ;
constexpr size_t WS_WRIN = WS_WPOOL + (size_t)2 * D * 512 * 2, WS_WROUT = WS_WRIN + (size_t)RET_N * D * 2, WS_WSIN = WS_WROUT + (size_t)D * 4096 * 2, WS_WSOUT = WS_WSIN + (size_t)SWA_N * D * 2;
constexpr size_t WS_END = WS_WSOUT + (size_t)D * D * 2;
constexpr int CW_BAR = 4096;

constexpr int RING_BYTES = 131072, MISC_OFF = RING_BYTES + 320, LDS_BYTES = 147456;

#define XB_TMO      128
#define XB_XCNT(j)  (256  + 64 * (j))
#define XB_XSUB(j)  (1280 + 64 * (j))
#define XB_XGEN(j)  (2304 + 64 * (j))
#define XB_TOP      3328
#define XB_TOPGEN   3392
#define XCD_BAR_WORDS 3456
#define XB_SPIN_CAP (1u << 18)
__device__ __forceinline__ unsigned xb_ld(unsigned* p)              { return __hip_atomic_load(p, __ATOMIC_RELAXED, __HIP_MEMORY_SCOPE_AGENT); }
__device__ __forceinline__ unsigned xb_add(unsigned* p, unsigned v) { return __hip_atomic_fetch_add(p, v, __ATOMIC_RELAXED, __HIP_MEMORY_SCOPE_AGENT); }
__device__ __forceinline__ unsigned xb_xcc_id() { return (unsigned)__builtin_amdgcn_s_getreg((3 << 11) | 20) & 0xFu; }
#define XB_SPIN(cond, bar) do { unsigned _sp = 0; while (cond) { __builtin_amdgcn_s_sleep(1); \
    if ((++_sp & 255u) == 0u) { if (xb_ld(&(bar)[XB_TMO])) break; if (_sp > XB_SPIN_CAP) { atomicAdd(&(bar)[XB_TMO], 1u); break; } } } } while (0)
struct XcdBarrier { unsigned* bar; unsigned x; volatile LAS unsigned* st; };
__device__ __forceinline__ XcdBarrier xcd_barrier_post(unsigned* bar, volatile LAS unsigned* st) {
    XcdBarrier b; b.bar = bar; b.x = xb_xcc_id(); b.st = st;
    if (threadIdx.x == 0) (void)xb_add(&bar[XB_XCNT(b.x)], 1u);
    return b;
}
__device__ __forceinline__ void xcd_barrier_complete(unsigned* bar, unsigned x, unsigned& nloc, unsigned& nx) {
    const unsigned G = gridDim.x * gridDim.y * gridDim.z;
    unsigned sum, cnt, mine, sp = 0u;
    for (;;) {
        sum = 0u; cnt = 0u; mine = 0u;
#pragma unroll
        for (unsigned j = 0; j < 16; ++j) { const unsigned c = xb_ld(&bar[XB_XCNT(j)]); sum += c; cnt += (c > 0u) ? 1u : 0u; mine = (j == x) ? c : mine; }
        if (sum == G) break;
        __builtin_amdgcn_s_sleep(1);
        if ((++sp & 255u) == 0u) { if (xb_ld(&bar[XB_TMO])) break; if (sp > XB_SPIN_CAP) { atomicAdd(&bar[XB_TMO], 1u); break; } }
    }
    nloc = mine > 0u ? mine : 1u; nx = cnt > 0u ? cnt : 1u;
}
__device__ __forceinline__ void xcd_barrier(const XcdBarrier& b) {
    asm volatile("s_waitcnt vmcnt(0)" ::: "memory");
    __syncthreads();
    if (threadIdx.x == 0) {
        unsigned* bar = b.bar;
        __builtin_amdgcn_s_waitcnt(0);
        unsigned nloc = b.st[0], nx = b.st[1];
        if (nloc == 0u) { xcd_barrier_complete(bar, b.x, nloc, nx); b.st[0] = nloc; b.st[1] = nx; }
        const unsigned old = xb_add(&bar[XB_XSUB(b.x)], 1u);
        const unsigned gen = old / nloc;
        if (old + 1u == (gen + 1u) * nloc) {
            __builtin_amdgcn_fence(__ATOMIC_RELEASE, "agent");
            asm volatile("s_waitcnt vmcnt(0)" ::: "memory");
            const unsigned og = xb_add(&bar[XB_TOP], 1u);
            const unsigned tg = og / nx;
            if (og + 1u == (tg + 1u) * nx) xb_add(&bar[XB_TOPGEN], 1u);
            else XB_SPIN(xb_ld(&bar[XB_TOPGEN]) == tg, bar);
            __builtin_amdgcn_fence(__ATOMIC_ACQUIRE, "agent");
            xb_add(&bar[XB_XGEN(b.x)], 1u);
            asm volatile("s_waitcnt vmcnt(0)" ::: "memory");
        } else {
            XB_SPIN(xb_ld(&bar[XB_XGEN(b.x)]) == gen, bar);
            __builtin_amdgcn_fence(__ATOMIC_ACQUIRE, "agent");
            asm volatile("s_waitcnt vmcnt(0)" ::: "memory");
        }
    }
    __syncthreads();
}

struct Frame {
    LAS unsigned char* lds;
    int tid, lane, wave, vcu, G;
};
#define LDS_WAIT() asm volatile("s_waitcnt lgkmcnt(0)" ::: "memory")
__device__ __forceinline__ Frame relaunder(const Frame& F0) { Frame F = F0; int t = threadIdx.x; asm volatile("" : "+v"(t)); F.tid = t; F.lane = t & 63; F.wave = __builtin_amdgcn_readfirstlane(t >> 6); return F; }

__device__ __forceinline__ void transpose_item(const float* W, int K, int N, bf16_t* WT, int k0, int n0, int drow0, LAS float* scr, int lane) {
#pragma unroll 8
    for (int i = 0; i < 32; ++i) { const int kk = 2 * i + (lane >> 5); scr[kk * 33 + (lane & 31)] = W[(size_t)(k0 + kk) * N + n0 + (lane & 31)]; }
    LDS_WAIT(); asm volatile("" ::: "memory");
    const int c = lane & 7;
#pragma unroll
    for (int j = 0; j < 4; ++j) { const int n = (lane >> 3) + 8 * j; const LAS float* s = scr + (8 * c) * 33 + n;
        u32x4 o; o.x = pk2(s[0 * 33], s[1 * 33]); o.y = pk2(s[2 * 33], s[3 * 33]); o.z = pk2(s[4 * 33], s[5 * 33]); o.w = pk2(s[6 * 33], s[7 * 33]);
        *(u32x4*)(WT + (size_t)(drow0 + n) * K + k0 + 8 * c) = o; }
    LDS_WAIT(); asm volatile("" ::: "memory");
}
__device__ __forceinline__ void convert_stack(const Frame& F0, const float* W, bf16_t* WT, int nmat, int K, int N, int mode) {
    const Frame F = relaunder(F0);
    LAS float* scr = (LAS float*)(F.lds + F.wave * 16384);
    const int gw = F.vcu * 8 + F.wave, NGW = F.G * 8;
    const int nblk = N / 32, per = (K / 64) * nblk, total = nmat * per;
    for (int it = gw; it < total; it += NGW) {
        const int mi = it / per, r = it - mi * per, kb = r / nblk, nb = r - kb * nblk, n0 = 32 * nb;
        int drow0 = n0;
        if (mode == 1) { const int hn = N / 2; drow0 = (n0 < hn) ? ((n0 >> 7) * 256 + (n0 & 127)) : (((n0 - hn) >> 7) * 256 + 128 + ((n0 - hn) & 127)); }
        else if (mode == 2) { const int t = n0 >> 8, w = n0 & 255; drow0 = t * 256 + ((w >> 5) & 1) * 128 + (w >> 6) * 32; }
        transpose_item(W + (size_t)mi * K * N, K, N, WT + (size_t)mi * K * N, 64 * kb, n0, drow0, scr, F.lane);
    }
}
__device__ __forceinline__ void sincos_dd(double ang, float& s, float& c) {
    const double q = rint(ang * 0.63661977236758134308);
    double r = fma(-q, 1.57079632679489655800e+00, ang); r = fma(-q, 6.12323399573676603587e-17, r);
    const int qi = (int)((long long)q & 3);
    const double r2 = r * r;
    double sp = -1.0 / 1307674368000.0; sp = fma(sp, r2, 1.0 / 6227020800.0); sp = fma(sp, r2, -1.0 / 39916800.0); sp = fma(sp, r2, 1.0 / 362880.0); sp = fma(sp, r2, -1.0 / 5040.0); sp = fma(sp, r2, 1.0 / 120.0); sp = fma(sp, r2, -1.0 / 6.0); sp = fma(sp * r2, r, r);
    double cp = 1.0 / 20922789888000.0; cp = fma(cp, r2, -1.0 / 87178291200.0); cp = fma(cp, r2, 1.0 / 479001600.0); cp = fma(cp, r2, -1.0 / 3628800.0); cp = fma(cp, r2, 1.0 / 40320.0); cp = fma(cp, r2, -1.0 / 720.0); cp = fma(cp, r2, 1.0 / 24.0); cp = fma(cp, r2, -0.5); cp = fma(cp, r2, 1.0);
    const double ss = (qi & 1) ? cp : sp, cc = (qi & 1) ? sp : cp;
    s = (float)((qi & 2) ? -ss : ss); c = (float)(((qi + 1) & 2) ? -cc : cc);
}
__device__ __forceinline__ void rope_tables(const Frame& F0, const int* pos, float* rc, float* rs, float* sc, float* ss) {
    const Frame F = relaunder(F0);
    const int gt = F.vcu * 512 + F.tid, NT = F.G * 512;
    for (int i = gt; i < M * 160; i += NT) {
        const int row = i / 160, j = i - row * 160;
        const double p = (double)pos[row];
        float s, c;
        if (j < 128) { const double invf = exp2(-(double)j * (13.287712379549449 / 127.0)); sincos_dd(p * invf, s, c); rc[(size_t)row * 128 + j] = c; rs[(size_t)row * 128 + j] = s; }
        else { const int jj = j - 128; const double invf = exp2(-(double)jj * (13.287712379549449 / 32.0)); sincos_dd(p * invf, s, c); sc[(size_t)row * 32 + jj] = c; ss[(size_t)row * 32 + jj] = s; }
    }
}

__device__ __forceinline__ void norm_phase(const Frame& F0, const float* hin, float* hout, const float* f, float alpha, const float* g1, const float* g2, bf16_t* u) {
    const Frame F = relaunder(F0);
    const int gw = F.vcu * 8 + F.wave, NGW = F.G * 8;
    for (int row = gw; row < M; row += NGW) {
        const f32x4* hr = (const f32x4*)(hin + (size_t)row * D) + F.lane;
        f32x4 hv[8];
#pragma unroll
        for (int j = 0; j < 8; ++j) hv[j] = hr[64 * j];
        if (f) {
            const f32x4* fr = (const f32x4*)(f + (size_t)row * D) + F.lane;
            f32x4 fv[8]; float ss = 0.f;
#pragma unroll
            for (int j = 0; j < 8; ++j) { fv[j] = fr[64 * j]; ss += (fv[j].x * fv[j].x + fv[j].y * fv[j].y) + (fv[j].z * fv[j].z + fv[j].w * fv[j].w); }
            const float rstd = alpha / sqrtf(wave_sum(ss) * (1.0f / D) + EPS);
#pragma unroll
            for (int j = 0; j < 8; ++j) { const f32x4 gv = ((const f32x4*)g1)[F.lane + 64 * j]; hv[j] = hv[j] + fv[j] * gv * rstd; }
        }
        if (hout) { f32x4* ho = (f32x4*)(hout + (size_t)row * D) + F.lane;
#pragma unroll
            for (int j = 0; j < 8; ++j) ho[64 * j] = hv[j]; }
        if (g2) {
            float ss = 0.f;
#pragma unroll
            for (int j = 0; j < 8; ++j) ss += (hv[j].x * hv[j].x + hv[j].y * hv[j].y) + (hv[j].z * hv[j].z + hv[j].w * hv[j].w);
            const float rstd = 1.0f / sqrtf(wave_sum(ss) * (1.0f / D) + EPS);
            u32x2* uo = (u32x2*)(u + (size_t)row * D) + F.lane;
#pragma unroll
            for (int j = 0; j < 8; ++j) { const f32x4 gv = ((const f32x4*)g2)[F.lane + 64 * j]; const f32x4 y = hv[j] * gv * rstd; u32x2 w; w.x = pk2(y.x, y.y); w.y = pk2(y.z, y.w); uo[64 * j] = w; }
        }
    }
}

__device__ __forceinline__ void pool_phase(const Frame& F0, const bf16_t* u, bf16_t* mixed) {
    const Frame F = relaunder(F0);
    const int gt = F.vcu * 512 + F.tid, NT = F.G * 512;
    for (int i = gt; i < M * (D / 8); i += NT) {
        const int row = i >> 8, c8 = i & 255, s = row & (SEQ - 1), w = 2 << (c8 >> 6);
        const int cnt = (s + 1 < w) ? (s + 1) : w;
        float a[8];
#pragma unroll
        for (int e = 0; e < 8; ++e) a[e] = 0.f;
        u32x4 self = (u32x4){0u, 0u, 0u, 0u};
        for (int k = 0; k < cnt; ++k) { const u32x4 v = *(const u32x4*)(u + (size_t)(row - k) * D + c8 * 8); if (k == 0) self = v;
            a[0] += bflo(v.x); a[1] += bfhi(v.x); a[2] += bflo(v.y); a[3] += bfhi(v.y); a[4] += bflo(v.z); a[5] += bfhi(v.z); a[6] += bflo(v.w); a[7] += bfhi(v.w); }
        const float inv = 1.0f / (float)cnt;
        u32x4 o;
        o.x = pk2(a[0] * inv - bflo(self.x), a[1] * inv - bfhi(self.x)); o.y = pk2(a[2] * inv - bflo(self.y), a[3] * inv - bfhi(self.y));
        o.z = pk2(a[4] * inv - bflo(self.z), a[5] * inv - bfhi(self.z)); o.w = pk2(a[6] * inv - bflo(self.w), a[7] * inv - bfhi(self.w));
        *(u32x4*)(mixed + (size_t)row * D + c8 * 8) = o;
    }
}

__device__ __forceinline__ void ds_tr4(unsigned a0, unsigned a1, unsigned a2, unsigned a3, bf16x8& f0, bf16x8& f1) {
    bf16x4 r0, r1, r2, r3;
    asm volatile("ds_read_b64_tr_b16 %0, %4\n\tds_read_b64_tr_b16 %1, %5\n\tds_read_b64_tr_b16 %2, %6\n\tds_read_b64_tr_b16 %3, %7\n\ts_waitcnt lgkmcnt(0)"
                 : "=&v"(r0), "=&v"(r1), "=&v"(r2), "=&v"(r3) : "v"(a0), "v"(a1), "v"(a2), "v"(a3) : "memory");
    f0 = __builtin_shufflevector(r0, r1, 0, 1, 2, 3, 4, 5, 6, 7); f1 = __builtin_shufflevector(r2, r3, 0, 1, 2, 3, 4, 5, 6, 7);
}
__device__ __forceinline__ bf16x8 pack8(const f32x4& a, const f32x4& b) {
    u32x4 w; w.x = pk2(a[0], a[1]); w.y = pk2(a[2], a[3]); w.z = pk2(b[0], b[1]); w.w = pk2(b[2], b[3]);
    return __builtin_bit_cast(bf16x8, w);
}

constexpr int RK_STR = 528, RV_STR = 80;
constexpr int R_KS = 0, R_VS = 128 * RK_STR, R_ST = R_VS + 128 * RV_STR, R_END = R_ST + 32 * RK_STR;
static_assert(R_END <= RING_BYTES, "retention LDS");
__device__ __forceinline__ void ret_core_phase(const Frame& F0, const bf16_t* hp, bf16_t* ro) {
    const Frame F = relaunder(F0);
    const int w = F.wave, lane = F.lane, l15 = lane & 15, g = lane >> 4, q = (lane & 15) >> 2, p = lane & 3;
    const unsigned ldsb = (unsigned)(size_t)F.lds;
    for (int item = F.vcu; item < 256; item += F.G) {
        const int b = item >> 7, hd = (item >> 4) & 7, vs = item & 15;
        const float l2g = log2_gamma(hd);
        const float g128 = __builtin_amdgcn_exp2f(128.0f * l2g);
        const bf16_t* qb = hp + (size_t)(b * SEQ) * RET_N + hd * 256;
        const bf16_t* kb = hp + (size_t)(b * SEQ) * RET_N + D + hd * 256;
        const bf16_t* vb = hp + (size_t)(b * SEQ) * RET_N + 2 * D + hd * 512 + vs * 32;
        bf16_t* ob = ro + (size_t)(b * SEQ) * 4096 + hd * 512 + vs * 32;
        f32x4 T[2][2];
#pragma unroll
        for (int a = 0; a < 2; ++a)
#pragma unroll
            for (int c = 0; c < 2; ++c) T[a][c] = (f32x4){0.f, 0.f, 0.f, 0.f};
        u32x4 kreg[8], vreg, qf[8];
#pragma unroll
        for (int i = 0; i < 8; ++i) { const int pc = F.tid + 512 * i, r = pc >> 5, c16 = pc & 31; kreg[i] = *(const u32x4*)(kb + (size_t)r * RET_N + c16 * 8); }
        { const int r = F.tid >> 2, c16 = F.tid & 3; vreg = *(const u32x4*)(vb + (size_t)r * RET_N + c16 * 8); }
#pragma unroll
        for (int ks = 0; ks < 8; ++ks) qf[ks] = *(const u32x4*)(qb + (size_t)(16 * w + l15) * RET_N + 32 * ks + 8 * g);
        for (int n = 0; n < 32; ++n) {
#pragma unroll
            for (int i = 0; i < 8; ++i) { const int pc = F.tid + 512 * i, r = pc >> 5, c16 = pc & 31; *(LAS u32x4*)(F.lds + R_KS + r * RK_STR + c16 * 16) = kreg[i]; }
            { const int r = F.tid >> 2, c16 = F.tid & 3; *(LAS u32x4*)(F.lds + R_VS + r * RV_STR + c16 * 16) = vreg; }
#pragma unroll
            for (int a = 0; a < 2; ++a)
#pragma unroll
                for (int c = 0; c < 2; ++c) { T[a][c] = T[a][c] * g128;
                    u32x2 wv; wv.x = pk2(T[a][c][0], T[a][c][1]); wv.y = pk2(T[a][c][2], T[a][c][3]);
                    *(LAS u32x2*)(F.lds + R_ST + (16 * c + l15) * RK_STR + (32 * w + 16 * a + 4 * g) * 2) = wv; }
            bf16x8 qc[8];
#pragma unroll
            for (int ks = 0; ks < 8; ++ks) qc[ks] = __builtin_bit_cast(bf16x8, qf[ks]);
            __syncthreads();
            { const int nn = (n + 1 < 32) ? n + 1 : n; const size_t ro0 = (size_t)(128 * nn) * RET_N;
#pragma unroll
              for (int i = 0; i < 8; ++i) { const int pc = F.tid + 512 * i, r = pc >> 5, c16 = pc & 31; kreg[i] = *(const u32x4*)(kb + ro0 + (size_t)r * RET_N + c16 * 8); }
              { const int r = F.tid >> 2, c16 = F.tid & 3; vreg = *(const u32x4*)(vb + ro0 + (size_t)r * RET_N + c16 * 8); }
#pragma unroll
              for (int ks = 0; ks < 8; ++ks) qf[ks] = *(const u32x4*)(qb + ro0 + (size_t)(16 * w + l15) * RET_N + 32 * ks + 8 * g); }
            f32x4 Pt[8];
#pragma unroll
            for (int jt = 0; jt < 8; ++jt) { Pt[jt] = (f32x4){0.f, 0.f, 0.f, 0.f};
                if (jt <= w) {
#pragma unroll
                    for (int ks = 0; ks < 8; ++ks) { const bf16x8 kf = *(const LAS bf16x8*)(F.lds + R_KS + (16 * jt + l15) * RK_STR + (32 * ks + 8 * g) * 2);
                        Pt[jt] = __builtin_amdgcn_mfma_f32_16x16x32_bf16(kf, qc[ks], Pt[jt], 0, 0, 0); }
                    if (jt == w) {
#pragma unroll
                        for (int r = 0; r < 4; ++r) if (4 * g + r > l15) Pt[jt][r] = 0.f; }
                } }
            f32x4 O[2];
#pragma unroll
            for (int vt = 0; vt < 2; ++vt) { O[vt] = (f32x4){0.f, 0.f, 0.f, 0.f};
#pragma unroll
                for (int ks = 0; ks < 8; ++ks) { const bf16x8 sf = *(const LAS bf16x8*)(F.lds + R_ST + (16 * vt + l15) * RK_STR + (32 * ks + 8 * g) * 2);
                    O[vt] = __builtin_amdgcn_mfma_f32_16x16x32_bf16(sf, qc[ks], O[vt], 0, 0, 0); } }
#pragma unroll
            for (int kk = 0; kk < 4; ++kk) {
                if (2 * kk <= w) {
                    const unsigned va = ldsb + R_VS + (32 * kk + 4 * g + q) * RV_STR + 4 * p * 2;
                    bf16x8 v0, v1; ds_tr4(va, va + 16 * RV_STR, va + 32, va + 16 * RV_STR + 32, v0, v1);
                    const bf16x8 pf = pack8(Pt[2 * kk], Pt[2 * kk + 1]);
                    O[0] = __builtin_amdgcn_mfma_f32_16x16x32_bf16(v0, pf, O[0], 0, 0, 0);
                    O[1] = __builtin_amdgcn_mfma_f32_16x16x32_bf16(v1, pf, O[1], 0, 0, 0);
                } }
            { bf16_t* orow = ob + (size_t)(128 * n + 16 * w + l15) * 4096;
#pragma unroll
              for (int vt = 0; vt < 2; ++vt) { u32x2 wv; wv.x = pk2(O[vt][0], O[vt][1]); wv.y = pk2(O[vt][2], O[vt][3]); *(u32x2*)(orow + 16 * vt + 4 * g) = wv; } }
#pragma unroll
            for (int kk = 0; kk < 4; ++kk) {
                const unsigned va = ldsb + R_VS + (32 * kk + 4 * g + q) * RV_STR + 4 * p * 2;
                const unsigned ka = ldsb + R_KS + (32 * kk + 4 * g + q) * RK_STR + (32 * w + 4 * p) * 2;
                bf16x8 v0, v1, k0, k1; ds_tr4(va, va + 16 * RV_STR, va + 32, va + 16 * RV_STR + 32, v0, v1);
                ds_tr4(ka, ka + 16 * RK_STR, ka + 32, ka + 16 * RK_STR + 32, k0, k1);
                T[0][0] = __builtin_amdgcn_mfma_f32_16x16x32_bf16(k0, v0, T[0][0], 0, 0, 0); T[0][1] = __builtin_amdgcn_mfma_f32_16x16x32_bf16(k0, v1, T[0][1], 0, 0, 0);
                T[1][0] = __builtin_amdgcn_mfma_f32_16x16x32_bf16(k1, v0, T[1][0], 0, 0, 0); T[1][1] = __builtin_amdgcn_mfma_f32_16x16x32_bf16(k1, v1, T[1][1], 0, 0, 0);
            }
            __syncthreads();
        }
    }
}

__device__ __forceinline__ void ret_gate_phase(const Frame& F0, const bf16_t* ro, const bf16_t* hp, const float* gng, const float* gnb, bf16_t* gt) {
    const Frame F = relaunder(F0);
    const int gw = F.vcu * 8 + F.wave, NGW = F.G * 8;
    for (int it = gw; it < M * 8; it += NGW) {
        const int row = it >> 3, hd = it & 7, c0 = hd * 512 + F.lane * 8;
        const u32x4 ov = *(const u32x4*)(ro + (size_t)row * 4096 + c0);
        const u32x4 gv = *(const u32x4*)(hp + (size_t)row * RET_N + 4 * D + c0);
        float o[8] = {bflo(ov.x), bfhi(ov.x), bflo(ov.y), bfhi(ov.y), bflo(ov.z), bfhi(ov.z), bflo(ov.w), bfhi(ov.w)};
        const float gg[8] = {bflo(gv.x), bfhi(gv.x), bflo(gv.y), bfhi(gv.y), bflo(gv.z), bfhi(gv.z), bflo(gv.w), bfhi(gv.w)};
        float s = 0.f;
#pragma unroll
        for (int e = 0; e < 8; ++e) s += o[e];
        const float mu = wave_sum(s) * (1.0f / 512.0f);
        float s2 = 0.f;
#pragma unroll
        for (int e = 0; e < 8; ++e) { o[e] -= mu; s2 += o[e] * o[e]; }
        const float rstd = 1.0f / sqrtf(wave_sum(s2) * (1.0f / 512.0f) + EPS);
        const f32x4 ga = *(const f32x4*)(gng + c0), gb = *(const f32x4*)(gng + c0 + 4), ba = *(const f32x4*)(gnb + c0), bb = *(const f32x4*)(gnb + c0 + 4);
        const float gn[8] = {ga[0], ga[1], ga[2], ga[3], gb[0], gb[1], gb[2], gb[3]}, bn[8] = {ba[0], ba[1], ba[2], ba[3], bb[0], bb[1], bb[2], bb[3]};
        float y[8];
#pragma unroll
        for (int e = 0; e < 8; ++e) y[e] = fast_silu(gg[e]) * (o[e] * rstd * gn[e] + bn[e]);
        u32x4 wv; wv.x = pk2(y[0], y[1]); wv.y = pk2(y[2], y[3]); wv.z = pk2(y[4], y[5]); wv.w = pk2(y[6], y[7]);
        *(u32x4*)(gt + (size_t)row * 4096 + c0) = wv;
    }
}

constexpr int SA_STR = 144;
constexpr int SA_KB = 0, SA_VB = 256 * SA_STR, SA_END = SA_VB + 272 * SA_STR;
static_assert(SA_END <= RING_BYTES, "swa LDS");
__device__ __forceinline__ void swa_attn_phase(const Frame& F0, const bf16_t* qkv, const float* sinks, bf16_t* ao) {
    const Frame F = relaunder(F0);
    const int w = F.wave, lane = F.lane, l15 = lane & 15, g = lane >> 4, q = (lane & 15) >> 2, p = lane & 3;
    const unsigned ldsb = (unsigned)(size_t)F.lds;
    for (int item = F.vcu; item < 256; item += F.G) {
        const int b = item >> 7, kvh = (item >> 5) & 3, nb = item & 31;
        const int hq = kvh * 8 + w;
        const float sink = sinks[hq];
        const int tok0 = b * SEQ + 128 * nb;
        __syncthreads();
#pragma unroll
        for (int i = 0; i < 4; ++i) { const int pc = F.tid + 512 * i, r = pc >> 3, c16 = pc & 7;
            unsigned z_ = 0u; asm volatile("" : "+v"(z_));
            u32x4 kv = (u32x4){z_, z_, z_, z_}, vv = kv;
            if (nb > 0 || r >= 128) { const bf16_t* src = qkv + (size_t)(tok0 - 128 + r) * SWA_N + 2048 + kvh * 64 + c16 * 8; kv = *(const u32x4*)src; vv = *(const u32x4*)(src + 256); }
            *(LAS u32x4*)(F.lds + SA_KB + r * SA_STR + c16 * 16) = kv; *(LAS u32x4*)(F.lds + SA_VB + r * SA_STR + c16 * 16) = vv; }
        if (F.tid < 128) { const int r = 256 + (F.tid >> 3), c16 = F.tid & 7; unsigned z_ = 0u; asm volatile("" : "+v"(z_)); *(LAS u32x4*)(F.lds + SA_VB + r * SA_STR + c16 * 16) = (u32x4){z_, z_, z_, z_}; }
        __syncthreads();
        for (int it = 0; it < 8; ++it) {
            const int row = tok0 + 16 * it + l15;
            bf16x8 qf[2];
#pragma unroll
            for (int ks = 0; ks < 2; ++ks) qf[ks] = __builtin_bit_cast(bf16x8, *(const u32x4*)(qkv + (size_t)row * SWA_N + hq * 64 + 32 * ks + 8 * g));
            f32x4 P[10];
            float mx = sink;
#pragma unroll
            for (int t = 0; t < 9; ++t) { const int jt = it + t; P[t] = (f32x4){0.f, 0.f, 0.f, 0.f};
#pragma unroll
                for (int ks = 0; ks < 2; ++ks) { const bf16x8 kf = *(const LAS bf16x8*)(F.lds + SA_KB + (16 * jt + l15) * SA_STR + (32 * ks + 8 * g) * 2);
                    P[t] = __builtin_amdgcn_mfma_f32_16x16x32_bf16(kf, qf[ks], P[t], 0, 0, 0); }
#pragma unroll
                for (int r = 0; r < 4; ++r) { const int jb = 16 * jt + 4 * g + r, diff = 16 * it + l15 + 128 - jb;
                    const bool ok = (diff >= 0) && (diff < 128) && (nb > 0 || jb >= 128);
                    const float sv = ok ? P[t][r] * 0.125f : -1e30f; P[t][r] = sv; mx = fmaxf(mx, sv); } }
            mx = fmaxf(mx, __shfl_xor(mx, 16)); mx = fmaxf(mx, __shfl_xor(mx, 32));
            float den = 0.f;
#pragma unroll
            for (int t = 0; t < 9; ++t)
#pragma unroll
                for (int r = 0; r < 4; ++r) { const float e = (P[t][r] > -1e29f) ? __builtin_amdgcn_exp2f((P[t][r] - mx) * 1.44269504089f) : 0.f; P[t][r] = e; den += e; }
            P[9] = (f32x4){0.f, 0.f, 0.f, 0.f};
            den += __shfl_xor(den, 16); den += __shfl_xor(den, 32);
            den += __builtin_amdgcn_exp2f((sink - mx) * 1.44269504089f);
            const float rden = 1.0f / den;
            f32x4 O[4];
#pragma unroll
            for (int dt = 0; dt < 4; ++dt) O[dt] = (f32x4){0.f, 0.f, 0.f, 0.f};
#pragma unroll
            for (int kk = 0; kk < 5; ++kk) {
                const bf16x8 pf = pack8(P[2 * kk], P[2 * kk + 1]);
                const unsigned va = ldsb + SA_VB + (16 * (it + 2 * kk) + 4 * g + q) * SA_STR + 4 * p * 2;
                bf16x8 v0, v1, v2, v3; ds_tr4(va, va + 16 * SA_STR, va + 32, va + 16 * SA_STR + 32, v0, v1); ds_tr4(va + 64, va + 16 * SA_STR + 64, va + 96, va + 16 * SA_STR + 96, v2, v3);
                O[0] = __builtin_amdgcn_mfma_f32_16x16x32_bf16(v0, pf, O[0], 0, 0, 0); O[1] = __builtin_amdgcn_mfma_f32_16x16x32_bf16(v1, pf, O[1], 0, 0, 0);
                O[2] = __builtin_amdgcn_mfma_f32_16x16x32_bf16(v2, pf, O[2], 0, 0, 0); O[3] = __builtin_amdgcn_mfma_f32_16x16x32_bf16(v3, pf, O[3], 0, 0, 0);
            }
            bf16_t* orow = ao + (size_t)row * D + hq * 64;
#pragma unroll
            for (int dt = 0; dt < 4; ++dt) { u32x2 wv; wv.x = pk2(O[dt][0] * rden, O[dt][1] * rden); wv.y = pk2(O[dt][2] * rden, O[dt][3] * rden); *(u32x2*)(orow + 16 * dt + 4 * g) = wv; }
        }
    }
}

constexpr int NPH = 61;
struct Args { const void* in[18]; float* out; unsigned char* ws; int ph_lo, ph_hi; };
typedef const Args __attribute__((address_space(4)))* KArgs;
__device__ __forceinline__ KArgs kargs() { KArgs p = (KArgs)__builtin_amdgcn_kernarg_segment_ptr(); asm volatile("" : "+s"(p)); return p; }
#define KIN(T, i) ((const T*)ka->in[i])
#define KWS(T, off) ((T*)(ka->ws + (off)))

__global__ void __launch_bounds__(512, 2) mk_fwd(Args args) {
    extern __shared__ __attribute__((aligned(16))) unsigned char lds_raw[];
    Frame F;
    F.lds = (LAS unsigned char*)lds_raw;
    F.tid = threadIdx.x; F.lane = F.tid & 63; F.wave = __builtin_amdgcn_readfirstlane(F.tid >> 6);
    F.G = gridDim.x; { const int bx = blockIdx.x; F.vcu = (F.G % 8 == 0) ? (bx % 8) * (F.G / 8) + bx / 8 : bx; }
    volatile LAS unsigned* MISC = (volatile LAS unsigned*)(F.lds + MISC_OFF);
    for (int u = F.tid; u < (LDS_BYTES - RING_BYTES) / 4; u += 512) ((LAS unsigned*)(F.lds + RING_BYTES))[u] = 0u;
    __syncthreads();
    const int lo = args.ph_lo, hi = args.ph_hi;
    XcdBarrier bar; bar.bar = (unsigned*)(args.ws + WS_CTL) + CW_BAR; bar.x = 0; bar.st = nullptr;
    if (hi - lo > 1) bar = xcd_barrier_post((unsigned*)(args.ws + WS_CTL) + CW_BAR, MISC + 8);
#define IN(k) (lo <= (k) && (k) < hi)
#define ENDP(k) do { if ((k) + 1 < hi) { XcdBarrier bb_ = bar; asm volatile("" : "+s"(bb_.bar)); xcd_barrier(bb_); } } while (0)

    if (IN(0)) {
        { KArgs ka = kargs(); convert_stack(F, KIN(float, 5), KWS(bf16_t, WS_WFFIN), 8, D, 2 * DFF, 1); }
        { KArgs ka = kargs(); convert_stack(F, KIN(float, 6), KWS(bf16_t, WS_WFFOUT), 8, DFF, D, 0); }
        { KArgs ka = kargs(); convert_stack(F, KIN(float, 7), KWS(bf16_t, WS_WPOOL), 8, 512, 512, 0); }
        { KArgs ka = kargs(); convert_stack(F, KIN(float, 9), KWS(bf16_t, WS_WRIN), 1, D, RET_N, 0); }
        { KArgs ka = kargs(); convert_stack(F, KIN(float, 12), KWS(bf16_t, WS_WROUT), 1, 2 * D, D, 0); }
        { KArgs ka = kargs(); convert_stack(F, KIN(float, 13), KWS(bf16_t, WS_WSIN), 1, D, SWA_N, 2); }
        { KArgs ka = kargs(); convert_stack(F, KIN(float, 16), KWS(bf16_t, WS_WSOUT), 1, D, D, 0); }
        { KArgs ka = kargs(); rope_tables(F, KIN(int, 1), KWS(float, WS_RCOS), KWS(float, WS_RSIN), KWS(float, WS_SCOS), KWS(float, WS_SSIN)); }
        { KArgs ka = kargs(); norm_phase(F, KIN(float, 0), nullptr, nullptr, 0.f, nullptr, KIN(float, 2), KWS(bf16_t, WS_U)); }
        ENDP(0);
    }

#pragma nounroll
    for (int L = 0; L < DEPTH; ++L) {
        const int pb = 1 + 16 * L, kind = L % 3;
#pragma nounroll
        for (int sub = 0; sub < 2; ++sub) {
            const int pf = pb + 9 * sub, wi = 2 * L + sub;
            if (IN(pf)) {
                KArgs ka = kargs();
                pg8::Gemm gm{KWS(bf16_t, WS_U), KWS(bf16_t, WS_WFFIN + (size_t)wi * W_FFIN_SZ), M, 2 * DFF, D, D, D};
                pg8::StaticOrder S; S.init(M, 2 * DFF, F.G, (int)blockIdx.x);
                pg8::EpiSwiglu E{KWS(bf16_t, WS_BIG), DFF};
                pg8::gemm_phase<pg8::EpiSwiglu, pg8::StaticOrder>(F.lds, gm, S, E);
                ENDP(pf);
            }
            if (IN(pf + 1)) {
                KArgs ka = kargs();
                pg8::Gemm gm{KWS(bf16_t, WS_BIG), KWS(bf16_t, WS_WFFOUT + (size_t)wi * W_FFOUT_SZ), M, D, DFF, DFF, DFF};
                pg8::StaticOrder S; S.init(M, D, F.G, (int)blockIdx.x);
                pg8::EpiF32 E{KWS(float, WS_F), D, nullptr, nullptr};
                pg8::gemm_phase<pg8::EpiF32, pg8::StaticOrder>(F.lds, gm, S, E);
                ENDP(pf + 1);
            }
            if (IN(pf + 2)) {
                KArgs ka = kargs();
                const float* gpost = (sub == 0 ? KIN(float, 2) : KIN(float, 4)) + (size_t)(L * 2 + 1) * D;
                const float* gnext = (sub == 0) ? KIN(float, 3) + (size_t)(L * 2) * D : (L + 1 < DEPTH ? KIN(float, 2) + (size_t)((L + 1) * 2) * D : nullptr);
                const float* hin = (L == 0 && sub == 0) ? KIN(float, 0) : KWS(float, WS_H);
                float* hout = (L + 1 == DEPTH && sub == 1) ? ka->out : KWS(float, WS_H);
                norm_phase(F, hin, hout, KWS(float, WS_F), 0.5f, gpost, gnext, KWS(bf16_t, WS_U));
                ENDP(pf + 2);
            }
            if (sub == 0) {
                const int pm = pb + 3;
                if (kind == 0) {
                    if (IN(pm)) { KArgs ka = kargs(); pool_phase(F, KWS(bf16_t, WS_U), KWS(bf16_t, WS_X2)); ENDP(pm); }
                } else if (kind == 1) {
                    if (IN(pm)) {
                        KArgs ka = kargs();
                        pg8::Gemm gm{KWS(bf16_t, WS_U), KWS(bf16_t, WS_WRIN), M, RET_N, D, D, D};
                        pg8::StaticOrder S; S.init(M, RET_N, F.G, (int)blockIdx.x);
                        pg8::EpiRetIn E{KWS(bf16_t, WS_BIG), KWS(float, WS_RCOS), KWS(float, WS_RSIN)};
                        pg8::gemm_phase<pg8::EpiRetIn, pg8::StaticOrder>(F.lds, gm, S, E);
                        ENDP(pm);
                    }
                    if (IN(pm + 1)) { KArgs ka = kargs(); ret_core_phase(F, KWS(bf16_t, WS_BIG), KWS(bf16_t, WS_RO)); ENDP(pm + 1); }
                    if (IN(pm + 2)) { KArgs ka = kargs(); ret_gate_phase(F, KWS(bf16_t, WS_RO), KWS(bf16_t, WS_BIG), KIN(float, 10), KIN(float, 11), KWS(bf16_t, WS_GT)); ENDP(pm + 2); }
                } else {
                    if (IN(pm)) {
                        KArgs ka = kargs();
                        pg8::Gemm gm{KWS(bf16_t, WS_U), KWS(bf16_t, WS_WSIN), M, SWA_N, D, D, D};
                        pg8::StaticOrder S; S.init(M, SWA_N, F.G, (int)blockIdx.x);
                        pg8::EpiSwaIn E{KWS(bf16_t, WS_BIG), KIN(float, 14), KWS(float, WS_SCOS), KWS(float, WS_SSIN)};
                        pg8::gemm_phase<pg8::EpiSwaIn, pg8::StaticOrder>(F.lds, gm, S, E);
                        ENDP(pm);
                    }
                    if (IN(pm + 1)) { KArgs ka = kargs(); swa_attn_phase(F, KWS(bf16_t, WS_BIG), KIN(float, 15), KWS(bf16_t, WS_X2)); ENDP(pm + 1); }
                }
                if (IN(pb + 7)) {
                    KArgs ka = kargs();
                    const int jm = L / 3;
                    pg8::Gemm gm; pg8::StaticOrder S; pg8::EpiF32 E{KWS(float, WS_F), D, nullptr, nullptr};
                    if (kind == 0) { gm = pg8::Gemm{KWS(bf16_t, WS_X2), KWS(bf16_t, WS_WPOOL + (size_t)jm * D * 512 * 2), M, D, 512, D, 512}; S.init(M, D, F.G, (int)blockIdx.x, 512); E.scale = KIN(float, 8) + (size_t)jm * D; }
                    else if (kind == 1) { gm = pg8::Gemm{KWS(bf16_t, WS_GT), KWS(bf16_t, WS_WROUT), M, D, 2 * D, 2 * D, 2 * D}; S.init(M, D, F.G, (int)blockIdx.x); }
                    else { gm = pg8::Gemm{KWS(bf16_t, WS_X2), KWS(bf16_t, WS_WSOUT), M, D, D, D, D}; S.init(M, D, F.G, (int)blockIdx.x); E.bias = KIN(float, 17); }
                    pg8::gemm_phase<pg8::EpiF32, pg8::StaticOrder>(F.lds, gm, S, E);
                    ENDP(pb + 7);
                }
                if (IN(pb + 8)) {
                    KArgs ka = kargs();
                    norm_phase(F, KWS(float, WS_H), KWS(float, WS_H), KWS(float, WS_F), 1.0f, KIN(float, 3) + (size_t)(L * 2 + 1) * D, KIN(float, 4) + (size_t)(L * 2) * D, KWS(bf16_t, WS_U));
                    ENDP(pb + 8);
                }
            }
        }
    }
#undef IN
#undef ENDP
}

static bool phase_exists(int p) {
    if (p == 0) return true;
    const int L = (p - 1) / 16, s = (p - 1) % 16, kind = L % 3;
    if (s <= 2 || (s >= 7 && s <= 11)) return true;
    if (s == 3) return true;
    if (s == 4) return kind != 0;
    if (s == 5) return kind == 1;
    return false;
}
extern "C" void kernel_launch(void* const* d_in, const int* in_sizes, int n_in, void* d_out, int out_size, void* d_ws, size_t ws_size, hipStream_t stream) {
    static int grid = 0;
    if (grid == 0) {
        if (n_in != 18 || in_sizes[0] != M * D || out_size != M * D || ws_size < WS_END) { fprintf(stderr, "kernel_launch: unexpected problem (n_in %d, in0 %d, out %d, ws %zu, need %zu)\n", n_in, n_in > 0 ? in_sizes[0] : -1, out_size, ws_size, (size_t)WS_END); grid = -1; return; }
        int dev = 0, cus = 0, per_cu = 0;
        if (hipGetDevice(&dev) != hipSuccess || hipDeviceGetAttribute(&cus, hipDeviceAttributeMultiprocessorCount, dev) != hipSuccess) { grid = -1; return; }
        if (hipFuncSetAttribute((const void*)mk_fwd, hipFuncAttributeMaxDynamicSharedMemorySize, LDS_BYTES) != hipSuccess) { fprintf(stderr, "kernel_launch: hipFuncSetAttribute failed\n"); grid = -1; return; }
        if (hipOccupancyMaxActiveBlocksPerMultiprocessor(&per_cu, (const void*)mk_fwd, 512, LDS_BYTES) != hipSuccess || per_cu < 1) fprintf(stderr, "kernel_launch: occupancy query says %d blocks per CU\n", per_cu);
        (void)hipGetLastError();
        grid = cus;
    }
    if (grid < 0) return;
    if (hipMemsetAsync((char*)d_ws + WS_CTL, 0, CTL_ZERO_BYTES, stream) != hipSuccess) return;
    Args a{};
    for (int i = 0; i < 18; ++i) a.in[i] = d_in[i];
    a.out = (float*)d_out; a.ws = (unsigned char*)d_ws;
#if MK_MEGA
    a.ph_lo = 0; a.ph_hi = NPH;
    hipLaunchKernelGGL(mk_fwd, dim3(grid), dim3(512), LDS_BYTES, stream, a);
#else
    for (int p = 0; p < NPH; ++p) { if (!phase_exists(p)) continue; a.ph_lo = p; a.ph_hi = p + 1; hipLaunchKernelGGL(mk_fwd, dim3(grid), dim3(512), LDS_BYTES, stream, a); }
#endif
}
```

```cpp
#include <hip/hip_runtime.h>
#include <cstdio>
#include <cstdint>

#ifndef MK_MEGA
#define MK_MEGA 1
#endif
#ifndef DUP_KIND
#define DUP_KIND 0
#endif
#define DUPN(k) ((DUP_KIND == (k)) ? 2 : 1)

#define LAS __attribute__((address_space(3)))
#define GAS __attribute__((address_space(1)))
typedef unsigned short bf16_t;
typedef short bf16x8 __attribute__((ext_vector_type(8)));
typedef short bf16x4 __attribute__((ext_vector_type(4)));
typedef float f32x4 __attribute__((ext_vector_type(4)));
typedef float f32x2 __attribute__((ext_vector_type(2)));
typedef unsigned u32x4 __attribute__((ext_vector_type(4)));
typedef unsigned u32x2 __attribute__((ext_vector_type(2)));

constexpr int D = 2048, SEQ = 4096, NB = 2, M = NB * SEQ, DFF = 5504, DEPTH = 4;
constexpr float EPS = 1e-6f;
constexpr int RET_N = 6 * D;
constexpr int SWA_N = 2560;

__device__ __forceinline__ unsigned f2bf(float f) { unsigned u = __builtin_bit_cast(unsigned, f); return (u + 0x7fffu + ((u >> 16) & 1u)) >> 16; }
__device__ __forceinline__ unsigned pk2(float lo, float hi) { return f2bf(lo) | (f2bf(hi) << 16); }
__device__ __forceinline__ float bf2f(unsigned short b) { return __builtin_bit_cast(float, (unsigned)b << 16); }
__device__ __forceinline__ float bflo(unsigned w) { return __builtin_bit_cast(float, w << 16); }
__device__ __forceinline__ float bfhi(unsigned w) { return __builtin_bit_cast(float, w & 0xffff0000u); }
__device__ __forceinline__ float wave_sum(float v) {
#pragma unroll
    for (int o = 1; o < 64; o <<= 1) v += __shfl_xor(v, o);
    return v;
}
__device__ __forceinline__ float log2_gamma(int hd) { const float e = ldexpf(1.0f, -5 - hd); float p = 1.0f / 7.0f; p = p * e + 1.0f / 6.0f; p = p * e + 0.2f; p = p * e + 0.25f; p = p * e + 1.0f / 3.0f; p = p * e + 0.5f; p = p * e + 1.0f; return -1.44269504089f * e * p; }
__device__ __forceinline__ float fast_silu(float x) { return x * __builtin_amdgcn_rcpf(1.0f + __builtin_amdgcn_exp2f(-1.44269504089f * x)); }

namespace pg8 {
constexpr int BM = 256, BK = 64, HALF = 128, HTB = HALF * BK * 2, STAGE_BYTES = 8 * HTB, NXCD = 8, WGM = 8;
__host__ __device__ __forceinline__ int lds_byte(int r, int c) { const int st = (r >> 4) * 2 + (c >> 5), rr = r & 15, cc = c & 31, ob = rr * 64 + cc * 2; return st * 1024 + (ob ^ (((ob >> 9) & 1) << 5)); }
__host__ __device__ __forceinline__ void stage_rc(int b, int& R, int& C) { const int st = b / 1024, sb = b % 1024, swz = sb ^ (((sb >> 9) & 1) << 5); R = (st >> 1) * 16 + swz / 64; C = (st & 1) * 32 + (swz % 64) / 2; }
__host__ __device__ __forceinline__ int perm32(int rho) { const int n = rho >> 4, i = rho & 15; return 8 * (i >> 2) + 4 * n + (i & 3); }

struct Unit { int pm, pn, ka; };
struct Gemm { const bf16_t* A; const bf16_t* Bt; int M, N, K, lda, ldb; };

struct StaticOrder {
    int nM, nN, nwg, G, c, kgrp;
    __host__ __device__ void init(int M_, int N_, int G_, int c_, int kgrp_ = 0) { nM = M_ / BM; nN = N_ / BM; nwg = nM * nN; G = G_; c = c_; kgrp = kgrp_; }
    __host__ __device__ bool next(int i, Unit& u) const {
        const long L = (long)i * G + c; if (L >= nwg) return false;
        int wgid = (int)L; { const int q = nwg / NXCD, r = nwg % NXCD, xcd = wgid % NXCD, off = wgid / NXCD; wgid = (xcd < r ? xcd * (q + 1) : r * (q + 1) + (xcd - r) * q) + off; }
        const int nig = WGM * nN, gid = wgid / nig, fm = gid * WGM, gsz = (nM - fm) < WGM ? (nM - fm) : WGM;
        u.pm = fm + ((wgid % nig) % gsz); u.pn = (wgid % nig) / gsz; u.ka = kgrp ? (u.pn >> 1) * kgrp : 0; return true;
    }
    __device__ __forceinline__ void a_ready(const Unit&) const {}
    __device__ __forceinline__ void done(const Unit&) const {}
};

struct EpiF32 {
    static constexpr bool PERM = false;
    float* C; int ldc; const float* bias; const float* scale;
    __device__ __forceinline__ void operator()(const f32x4 (&acc)[2][2][4][2], const Unit& u, int wr, int wc, int fr, int fq) const {
        const int row0 = u.pm * BM + wr * 64 + fr, col0 = u.pn * BM + wc * 32 + 4 * fq;
        f32x4 bv[2][2], sv[2][2];
#pragma unroll
        for (int bj = 0; bj < 2; ++bj)
#pragma unroll
            for (int n = 0; n < 2; ++n) { bv[bj][n] = bias ? *(const f32x4*)(bias + col0 + bj * HALF + n * 16) : (f32x4){0.f, 0.f, 0.f, 0.f};
                                          sv[bj][n] = scale ? *(const f32x4*)(scale + col0 + bj * HALF + n * 16) : (f32x4){1.f, 1.f, 1.f, 1.f}; }
#pragma unroll
        for (int ai = 0; ai < 2; ++ai)
#pragma unroll
            for (int m = 0; m < 4; ++m) { float* rowp = C + (size_t)(row0 + ai * HALF + m * 16) * ldc + col0;
#pragma unroll
                for (int bj = 0; bj < 2; ++bj)
#pragma unroll
                    for (int n = 0; n < 2; ++n) *(f32x4*)(rowp + bj * HALF + n * 16) = (acc[ai][bj][m][n] + bv[bj][n]) * sv[bj][n]; }
    }
};
struct EpiSwiglu {
    static constexpr bool PERM = true;
    bf16_t* O; int ldc;
    __device__ __forceinline__ void operator()(const f32x4 (&acc)[2][2][4][2], const Unit& u, int wr, int wc, int fr, int fq) const {
        const int row0 = u.pm * BM + wr * 64 + fr, col0 = u.pn * HALF + wc * 32 + 8 * fq;
#pragma unroll
        for (int ai = 0; ai < 2; ++ai)
#pragma unroll
            for (int m = 0; m < 4; ++m) {
                const f32x4 g0 = acc[ai][0][m][0], g1 = acc[ai][0][m][1], u0 = acc[ai][1][m][0], u1 = acc[ai][1][m][1];
                u32x4 w;
                w.x = pk2(fast_silu(g0[0]) * u0[0], fast_silu(g0[1]) * u0[1]); w.y = pk2(fast_silu(g0[2]) * u0[2], fast_silu(g0[3]) * u0[3]);
                w.z = pk2(fast_silu(g1[0]) * u1[0], fast_silu(g1[1]) * u1[1]); w.w = pk2(fast_silu(g1[2]) * u1[2], fast_silu(g1[3]) * u1[3]);
                *(u32x4*)(O + (size_t)(row0 + ai * HALF + m * 16) * ldc + col0) = w; }
    }
};
struct EpiRetIn {
    static constexpr bool PERM = true;
    bf16_t* O; const float* cs; const float* sn;
    __device__ __forceinline__ void operator()(const f32x4 (&acc)[2][2][4][2], const Unit& u, int wr, int wc, int fr, int fq) const {
        const int row0 = u.pm * BM + wr * 64 + fr, j0 = wc * 32 + 8 * fq;
        if (u.pn < 16) {
            const int hd = u.pn & 7; const bool isq = u.pn < 8;
            const float l2g = log2_gamma(hd);
#pragma unroll
            for (int ai = 0; ai < 2; ++ai)
#pragma unroll
                for (int m = 0; m < 4; ++m) { const int row = row0 + ai * HALF + m * 16; const int ic = row & 127;
                    const float dsc = isq ? __builtin_amdgcn_exp2f(l2g * (float)ic) : 0.0625f * __builtin_amdgcn_exp2f(-l2g * (float)ic);
                    const f32x4 c0 = *(const f32x4*)(cs + (size_t)row * 128 + j0), c1 = *(const f32x4*)(cs + (size_t)row * 128 + j0 + 4);
                    const f32x4 s0 = *(const f32x4*)(sn + (size_t)row * 128 + j0), s1 = *(const f32x4*)(sn + (size_t)row * 128 + j0 + 4);
                    const f32x4 a0 = acc[ai][0][m][0], a1 = acc[ai][0][m][1], b0 = acc[ai][1][m][0], b1 = acc[ai][1][m][1];
                    const f32x4 x0 = (a0 * c0 - b0 * s0) * dsc, x1 = (a1 * c1 - b1 * s1) * dsc, y0 = (b0 * c0 + a0 * s0) * dsc, y1 = (b1 * c1 + a1 * s1) * dsc;
                    u32x4 w0, w1; w0.x = pk2(x0[0], x0[1]); w0.y = pk2(x0[2], x0[3]); w0.z = pk2(x1[0], x1[1]); w0.w = pk2(x1[2], x1[3]);
                    w1.x = pk2(y0[0], y0[1]); w1.y = pk2(y0[2], y0[3]); w1.z = pk2(y1[0], y1[1]); w1.w = pk2(y1[2], y1[3]);
                    bf16_t* rowp = O + (size_t)row * RET_N + u.pn * BM + j0;
                    *(u32x4*)(rowp) = w0; *(u32x4*)(rowp + HALF) = w1; }
        } else {
#pragma unroll
            for (int ai = 0; ai < 2; ++ai)
#pragma unroll
                for (int m = 0; m < 4; ++m) { bf16_t* rowp = O + (size_t)(row0 + ai * HALF + m * 16) * RET_N + u.pn * BM + j0;
#pragma unroll
                    for (int bj = 0; bj < 2; ++bj) { const f32x4 v0 = acc[ai][bj][m][0], v1 = acc[ai][bj][m][1];
                        u32x4 w; w.x = pk2(v0[0], v0[1]); w.y = pk2(v0[2], v0[3]); w.z = pk2(v1[0], v1[1]); w.w = pk2(v1[2], v1[3]);
                        *(u32x4*)(rowp + bj * HALF) = w; } }
        }
    }
};
struct EpiSwaIn {
    static constexpr bool PERM = true;
    bf16_t* O; const float* bias; const float* cs; const float* sn;
    __device__ __forceinline__ void operator()(const f32x4 (&acc)[2][2][4][2], const Unit& u, int wr, int wc, int fr, int fq) const {
        const int row0 = u.pm * BM + wr * 64 + fr, j0 = 8 * fq, cbase = u.pn * BM + 64 * wc;
        const f32x4 ba0 = *(const f32x4*)(bias + cbase + j0), ba1 = *(const f32x4*)(bias + cbase + j0 + 4), bb0 = *(const f32x4*)(bias + cbase + 32 + j0), bb1 = *(const f32x4*)(bias + cbase + 32 + j0 + 4);
        const bool rot = u.pn < 9;
#pragma unroll
        for (int ai = 0; ai < 2; ++ai)
#pragma unroll
            for (int m = 0; m < 4; ++m) { const int row = row0 + ai * HALF + m * 16;
                f32x4 c0 = (f32x4){1.f, 1.f, 1.f, 1.f}, c1 = c0, s0 = (f32x4){0.f, 0.f, 0.f, 0.f}, s1 = s0;
                if (rot) { c0 = *(const f32x4*)(cs + (size_t)row * 32 + j0); c1 = *(const f32x4*)(cs + (size_t)row * 32 + j0 + 4); s0 = *(const f32x4*)(sn + (size_t)row * 32 + j0); s1 = *(const f32x4*)(sn + (size_t)row * 32 + j0 + 4); }
                const f32x4 a0 = acc[ai][0][m][0] + ba0, a1 = acc[ai][0][m][1] + ba1, b0 = acc[ai][1][m][0] + bb0, b1 = acc[ai][1][m][1] + bb1;
                const f32x4 x0 = a0 * c0 - b0 * s0, x1 = a1 * c1 - b1 * s1, y0 = b0 * c0 + a0 * s0, y1 = b1 * c1 + a1 * s1;
                u32x4 w0, w1; w0.x = pk2(x0[0], x0[1]); w0.y = pk2(x0[2], x0[3]); w0.z = pk2(x1[0], x1[1]); w0.w = pk2(x1[2], x1[3]);
                w1.x = pk2(y0[0], y0[1]); w1.y = pk2(y0[2], y0[3]); w1.z = pk2(y1[0], y1[1]); w1.w = pk2(y1[2], y1[3]);
                bf16_t* rowp = O + (size_t)row * SWA_N + cbase + j0;
                *(u32x4*)(rowp) = w0; *(u32x4*)(rowp + 32) = w1; }
    }
};

template <class Epi, class Sched>
__device__ __forceinline__ void gemm_phase(LAS unsigned char* lds, const Gemm g, const Sched& S, const Epi& E) {
    int tid_ = threadIdx.x; asm volatile("" : "+v"(tid_));
    const int tid = tid_, wid = __builtin_amdgcn_readfirstlane(tid >> 6), lane = tid & 63, wr = wid >> 2, wc = wid & 3, fr = lane & 15, fq = lane >> 4;
    const int K = g.K, nt = K / BK;
    unsigned voffA[2], voffB[2];
#pragma unroll
    for (int i = 0; i < 2; ++i) { int R, C; stage_rc(tid * 16 + i * 8192, R, C); const int Rb = Epi::PERM ? ((R & ~31) + perm32(R & 31)) : R;
        voffA[i] = (unsigned)(R * g.lda + C) * 2u; voffB[i] = (unsigned)(Rb * g.ldb + C) * 2u; }
    const size_t kstep = (size_t)(BK * 2);
    const size_t hstepA = (size_t)HALF * g.lda * 2, hstepB = (size_t)HALF * g.ldb * 2;
    const size_t tstepA = 2 * hstepA, tstepB = 2 * hstepB;
    const unsigned ldsw = (unsigned)wid * 1024u;
    const int aoff = lds_byte(wr * 64 + fr, fq * 8), boff = lds_byte(wc * 32 + fr, fq * 8);
#define PG8_SA(b, h) (((b) * 2 + (h)) * HTB)
#define PG8_SB(b, h) ((4 + (b) * 2 + (h)) * HTB)
#define PG8_STAGE(bufoff, gbase, voff) do { _Pragma("unroll") for (int _i = 0; _i < 2; ++_i) \
        __builtin_amdgcn_global_load_lds((const unsigned*)((const char*)(gbase) + (voff)[_i]), (LAS unsigned*)(lds + (bufoff) + ldsw + _i * 8192), 16, 0, 0); } while (0)
#define PG8_LDA(dst, b, h) do { _Pragma("unroll") for (int m = 0; m < 4; ++m) _Pragma("unroll") for (int k = 0; k < 2; ++k) dst[m][k] = *(const LAS bf16x8*)(lds + PG8_SA(b, h) + aoff + m * 2048 + k * 1024); } while (0)
#define PG8_LDB(dst, b, h) do { _Pragma("unroll") for (int n = 0; n < 2; ++n) _Pragma("unroll") for (int k = 0; k < 2; ++k) dst[n][k] = *(const LAS bf16x8*)(lds + PG8_SB(b, h) + boff + n * 2048 + k * 1024); } while (0)
#define PG8_MMA(ai, bj, At, Bt) do { __builtin_amdgcn_s_setprio(1); _Pragma("unroll") for (int m = 0; m < 4; ++m) _Pragma("unroll") for (int n = 0; n < 2; ++n) _Pragma("unroll") for (int k = 0; k < 2; ++k) \
        acc[ai][bj][m][n] = __builtin_amdgcn_mfma_f32_16x16x32_bf16(Bt[n][k], At[m][k], acc[ai][bj][m][n], 0, 0, 0); __builtin_amdgcn_s_setprio(0); } while (0)
#define PG8_WAIT_V(n) asm volatile("s_waitcnt vmcnt(" #n ")" ::: "memory")
#define PG8_WAIT_L(n) asm volatile("s_waitcnt lgkmcnt(" #n ")" ::: "memory")
#define PG8_BAR __builtin_amdgcn_s_barrier()
#define PG8_SCHED __builtin_amdgcn_sched_barrier(0)
    Unit cur, nxt; int ui = 0;
    if (!S.next(0, cur)) return;
    f32x4 acc[2][2][4][2];
#pragma unroll
    for (int a = 0; a < 2; ++a)
#pragma unroll
        for (int b = 0; b < 2; ++b)
#pragma unroll
            for (int m = 0; m < 4; ++m)
#pragma unroll
                for (int n = 0; n < 2; ++n) acc[a][b][m][n] = (f32x4){0.f, 0.f, 0.f, 0.f};
    bf16x8 At[4][2], B0[2][2], B1[2][2];
    const char* cA = (const char*)g.A + (size_t)cur.pm * tstepA + (size_t)cur.ka * 2; const char* cB = (const char*)g.Bt + (size_t)cur.pn * tstepB;
    S.a_ready(cur);
    PG8_STAGE(PG8_SB(0, 0), cB, voffB); PG8_STAGE(PG8_SB(0, 1), cB + hstepB, voffB); PG8_STAGE(PG8_SA(0, 0), cA, voffA); PG8_STAGE(PG8_SA(0, 1), cA + hstepA, voffA);
    if (wr == 1) PG8_BAR;
    PG8_WAIT_V(2); PG8_BAR;
    PG8_STAGE(PG8_SB(1, 0), cB + kstep, voffB); PG8_STAGE(PG8_SA(1, 0), cA + kstep, voffA); PG8_STAGE(PG8_SB(1, 1), cB + hstepB + kstep, voffB);
    PG8_WAIT_V(6); PG8_BAR;
    for (;;) {
        const bool has_next = S.next(ui + 1, nxt);
        const char* nA = has_next ? (const char*)g.A + (size_t)nxt.pm * tstepA + (size_t)nxt.ka * 2 : cA; const char* nB = has_next ? (const char*)g.Bt + (size_t)nxt.pn * tstepB : cB;
        for (int t = 0; t < nt; t += 2) {
            const bool last = (t == nt - 2);
            const char* a1 = cA + (size_t)(t + 1) * kstep;
            const char* a2 = last ? nA : cA + (size_t)(t + 2) * kstep; const char* b2 = last ? nB : cB + (size_t)(t + 2) * kstep;
            const char* a3 = a2 + kstep; const char* b3 = b2 + kstep;
            if (last && has_next) S.a_ready(nxt);
            PG8_LDB(B0, 0, 0); PG8_LDB(B1, 0, 1); PG8_SCHED; PG8_LDA(At, 0, 0); PG8_STAGE(PG8_SA(1, 1), a1 + hstepA, voffA);
            PG8_WAIT_V(8); PG8_WAIT_L(0); PG8_BAR; PG8_MMA(0, 0, At, B0); PG8_MMA(0, 1, At, B1); PG8_BAR; PG8_SCHED;
            PG8_LDA(At, 0, 1); PG8_STAGE(PG8_SB(0, 0), b2, voffB); PG8_STAGE(PG8_SB(0, 1), b2 + hstepB, voffB); PG8_STAGE(PG8_SA(0, 0), a2, voffA);
            PG8_WAIT_V(8); PG8_WAIT_L(0); PG8_BAR; PG8_MMA(1, 0, At, B0); PG8_MMA(1, 1, At, B1); PG8_BAR; PG8_SCHED;
            PG8_LDB(B0, 1, 0); PG8_LDB(B1, 1, 1); PG8_SCHED; PG8_LDA(At, 1, 0); PG8_STAGE(PG8_SA(0, 1), a2 + hstepA, voffA);
            PG8_WAIT_V(8); PG8_WAIT_L(0); PG8_BAR; PG8_MMA(0, 0, At, B0); PG8_MMA(0, 1, At, B1); PG8_BAR; PG8_SCHED;
            PG8_LDA(At, 1, 1); PG8_STAGE(PG8_SB(1, 0), b3, voffB); PG8_STAGE(PG8_SB(1, 1), b3 + hstepB, voffB); PG8_STAGE(PG8_SA(1, 0), a3, voffA);
            PG8_WAIT_V(8); PG8_WAIT_L(0); PG8_BAR; PG8_MMA(1, 0, At, B0); PG8_MMA(1, 1, At, B1); PG8_BAR; PG8_SCHED;
        }
        if (wr == 0) PG8_BAR;
        E(acc, cur, wr, wc, fr, fq); S.done(cur);
        if (!has_next) break;
#pragma unroll
        for (int a = 0; a < 2; ++a)
#pragma unroll
            for (int b = 0; b < 2; ++b)
#pragma unroll
                for (int m = 0; m < 4; ++m)
#pragma unroll
                    for (int n = 0; n < 2; ++n) acc[a][b][m][n] = (f32x4){0.f, 0.f, 0.f, 0.f};
        cur = nxt; cA = nA; cB = nB; ++ui;
        if (wr == 1) PG8_BAR;
    }
    PG8_WAIT_V(0);
    PG8_BAR;
#undef PG8_SA
#undef PG8_SB
#undef PG8_STAGE
#undef PG8_LDA
#undef PG8_LDB
#undef PG8_MMA
#undef PG8_WAIT_V
#undef PG8_WAIT_L
#undef PG8_BAR
#undef PG8_SCHED
}
}

constexpr size_t MiB = 1u << 20;
constexpr size_t WS_CTL = 0, CTL_ZERO_BYTES = 1 * MiB;
constexpr size_t WS_RCOS = 2 * MiB, WS_RSIN = 6 * MiB, WS_SCOS = 10 * MiB, WS_SSIN = 11 * MiB;
constexpr size_t WS_H = 16 * MiB;
constexpr size_t WS_F = 80 * MiB;
constexpr size_t WS_U = 144 * MiB;
constexpr size_t WS_X2 = 176 * MiB;
constexpr size_t WS_BIG = 208 * MiB;
constexpr size_t WS_RO = 400 * MiB;
constexpr size_t WS_GT = 464 * MiB;
constexpr size_t WS_W = 528 * MiB;
constexpr size_t W_FFIN_SZ = (size_t)2 * DFF * D * 2, W_FFOUT_SZ = (size_t)D * DFF * 2;
constexpr size_t WS_WFFIN = WS_W, WS_WFFOUT = WS_WFFIN + 8 * W_FFIN_SZ, WS_WPOOL = WS_WFFOUT + 8 * W_FFOUT_SZ;
constexpr size_t WS_WRIN = WS_WPOOL + (size_t)2 * D * 512 * 2, WS_WROUT = WS_WRIN + (size_t)RET_N * D * 2, WS_WSIN = WS_WROUT + (size_t)D * 4096 * 2, WS_WSOUT = WS_WSIN + (size_t)SWA_N * D * 2;
constexpr size_t WS_END = WS_WSOUT + (size_t)D * D * 2;
constexpr int CW_BAR = 4096;

constexpr int RING_BYTES = 131072, MISC_OFF = RING_BYTES + 320, LDS_BYTES = 147456;

#define XB_TMO      128
#define XB_XCNT(j)  (256  + 64 * (j))
#define XB_XSUB(j)  (1280 + 64 * (j))
#define XB_XGEN(j)  (2304 + 64 * (j))
#define XB_TOP      3328
#define XB_TOPGEN   3392
#define XCD_BAR_WORDS 3456
#define XB_SPIN_CAP (1u << 18)
__device__ __forceinline__ unsigned xb_ld(unsigned* p)              { return __hip_atomic_load(p, __ATOMIC_RELAXED, __HIP_MEMORY_SCOPE_AGENT); }
__device__ __forceinline__ unsigned xb_add(unsigned* p, unsigned v) { return __hip_atomic_fetch_add(p, v, __ATOMIC_RELAXED, __HIP_MEMORY_SCOPE_AGENT); }
__device__ __forceinline__ unsigned xb_xcc_id() { return (unsigned)__builtin_amdgcn_s_getreg((3 << 11) | 20) & 0xFu; }
#define XB_SPIN(cond, bar) do { unsigned _sp = 0; while (cond) { __builtin_amdgcn_s_sleep(1); \
    if ((++_sp & 255u) == 0u) { if (xb_ld(&(bar)[XB_TMO])) break; if (_sp > XB_SPIN_CAP) { atomicAdd(&(bar)[XB_TMO], 1u); break; } } } } while (0)
struct XcdBarrier { unsigned* bar; unsigned x; volatile LAS unsigned* st; };
__device__ __forceinline__ XcdBarrier xcd_barrier_post(unsigned* bar, volatile LAS unsigned* st) {
    XcdBarrier b; b.bar = bar; b.x = xb_xcc_id(); b.st = st;
    if (threadIdx.x == 0) (void)xb_add(&bar[XB_XCNT(b.x)], 1u);
    return b;
}
__device__ __forceinline__ void xcd_barrier_complete(unsigned* bar, unsigned x, unsigned& nloc, unsigned& nx) {
    const unsigned G = gridDim.x * gridDim.y * gridDim.z;
    unsigned sum, cnt, mine, sp = 0u;
    for (;;) {
        sum = 0u; cnt = 0u; mine = 0u;
#pragma unroll
        for (unsigned j = 0; j < 16; ++j) { const unsigned c = xb_ld(&bar[XB_XCNT(j)]); sum += c; cnt += (c > 0u) ? 1u : 0u; mine = (j == x) ? c : mine; }
        if (sum == G) break;
        __builtin_amdgcn_s_sleep(1);
        if ((++sp & 255u) == 0u) { if (xb_ld(&bar[XB_TMO])) break; if (sp > XB_SPIN_CAP) { atomicAdd(&bar[XB_TMO], 1u); break; } }
    }
    nloc = mine > 0u ? mine : 1u; nx = cnt > 0u ? cnt : 1u;
}
__device__ __forceinline__ void xcd_barrier(const XcdBarrier& b) {
    asm volatile("s_waitcnt vmcnt(0)" ::: "memory");
    __syncthreads();
    if (threadIdx.x == 0) {
        unsigned* bar = b.bar;
        __builtin_amdgcn_s_waitcnt(0);
        unsigned nloc = b.st[0], nx = b.st[1];
        if (nloc == 0u) { xcd_barrier_complete(bar, b.x, nloc, nx); b.st[0] = nloc; b.st[1] = nx; }
        const unsigned old = xb_add(&bar[XB_XSUB(b.x)], 1u);
        const unsigned gen = old / nloc;
        if (old + 1u == (gen + 1u) * nloc) {
            __builtin_amdgcn_fence(__ATOMIC_RELEASE, "agent");
            asm volatile("s_waitcnt vmcnt(0)" ::: "memory");
            const unsigned og = xb_add(&bar[XB_TOP], 1u);
            const unsigned tg = og / nx;
            if (og + 1u == (tg + 1u) * nx) xb_add(&bar[XB_TOPGEN], 1u);
            else XB_SPIN(xb_ld(&bar[XB_TOPGEN]) == tg, bar);
            __builtin_amdgcn_fence(__ATOMIC_ACQUIRE, "agent");
            xb_add(&bar[XB_XGEN(b.x)], 1u);
            asm volatile("s_waitcnt vmcnt(0)" ::: "memory");
        } else {
            XB_SPIN(xb_ld(&bar[XB_XGEN(b.x)]) == gen, bar);
            __builtin_amdgcn_fence(__ATOMIC_ACQUIRE, "agent");
            asm volatile("s_waitcnt vmcnt(0)" ::: "memory");
        }
    }
    __syncthreads();
}

struct Frame {
    LAS unsigned char* lds;
    int tid, lane, wave, vcu, G;
};
#define LDS_WAIT() asm volatile("s_waitcnt lgkmcnt(0)" ::: "memory")
__device__ __forceinline__ Frame relaunder(const Frame& F0) { Frame F = F0; int t = threadIdx.x; asm volatile("" : "+v"(t)); F.tid = t; F.lane = t & 63; F.wave = __builtin_amdgcn_readfirstlane(t >> 6); return F; }

__device__ __forceinline__ void transpose_item(const float* W, int K, int N, bf16_t* WT, int k0, int n0, int drow0, LAS float* scr, int lane) {
    float wv[32];
    { const float* wp = W + (size_t)(k0 + (lane >> 5)) * N + n0 + (lane & 31);
#pragma unroll
      for (int i = 0; i < 32; ++i) wv[i] = __builtin_nontemporal_load(wp + (size_t)(2 * i) * N); }
#pragma unroll
    for (int i = 0; i < 32; ++i) { const int kk = 2 * i + (lane >> 5); scr[kk * 33 + (lane & 31)] = wv[i]; }
    LDS_WAIT(); asm volatile("" ::: "memory");
    const int c = lane & 7;
#pragma unroll
    for (int j = 0; j < 4; ++j) { const int n = (lane >> 3) + 8 * j; const LAS float* s = scr + (8 * c) * 33 + n;
        u32x4 o; o.x = pk2(s[0 * 33], s[1 * 33]); o.y = pk2(s[2 * 33], s[3 * 33]); o.z = pk2(s[4 * 33], s[5 * 33]); o.w = pk2(s[6 * 33], s[7 * 33]);
        *(u32x4*)(WT + (size_t)(drow0 + n) * K + k0 + 8 * c) = o; }
    LDS_WAIT(); asm volatile("" ::: "memory");
}
__device__ __forceinline__ void convert_stack(const Frame& F0, const float* W, bf16_t* WT, int nmat, int K, int N, int mode) {
    const Frame F = relaunder(F0);
    LAS float* scr = (LAS float*)(F.lds + F.wave * 16384);
    const int gw = F.vcu * 8 + F.wave, NGW = F.G * 8;
    const int nblk = N / 32, per = (K / 64) * nblk, total = nmat * per;
    for (int it = gw; it < total; it += NGW) {
        const int mi = it / per, r = it - mi * per, kb = r / nblk, nb = r - kb * nblk, n0 = 32 * nb;
        int drow0 = n0;
        if (mode == 1) { const int hn = N / 2; drow0 = (n0 < hn) ? ((n0 >> 7) * 256 + (n0 & 127)) : (((n0 - hn) >> 7) * 256 + 128 + ((n0 - hn) & 127)); }
        else if (mode == 2) { const int t = n0 >> 8, w = n0 & 255; drow0 = t * 256 + ((w >> 5) & 1) * 128 + (w >> 6) * 32; }
        transpose_item(W + (size_t)mi * K * N, K, N, WT + (size_t)mi * K * N, 64 * kb, n0, drow0, scr, F.lane);
    }
}
__device__ __forceinline__ void conv_one(const float* W, bf16_t* WT, int K, int N, int mode, int r, LAS float* scr, int lane) {
    const int nblk = N / 32, kb = r / nblk, nb = r - kb * nblk, n0 = 32 * nb;
    int drow0 = n0;
    if (mode == 1) { const int hn = N / 2; drow0 = (n0 < hn) ? ((n0 >> 7) * 256 + (n0 & 127)) : (((n0 - hn) >> 7) * 256 + 128 + ((n0 - hn) & 127)); }
    else if (mode == 2) { const int t = n0 >> 8, w = n0 & 255; drow0 = t * 256 + ((w >> 5) & 1) * 128 + (w >> 6) * 32; }
    transpose_item(W, K, N, WT, 64 * kb, n0, drow0, scr, lane);
}
constexpr int CW_QUEUE = 8192;
constexpr int IT_FFIN = (D / 64) * (2 * DFF / 32), IT_FFOUT = (DFF / 64) * (D / 32), IT_RIN = (D / 64) * (RET_N / 32), IT_ROUT = (2 * D / 64) * (D / 32), IT_SIN = (D / 64) * (SWA_N / 32), IT_SOUT = (D / 64) * (D / 32);
template <class KA> __device__ __forceinline__ void convert_tail(const Frame& F0, KA ka, int k) {
    const Frame F = relaunder(F0);
    unsigned char* ws = ka->ws;
    LAS float* scr = (LAS float*)(F.lds + F.wave * 16384);
    unsigned* head = (unsigned*)(ws + WS_CTL) + CW_QUEUE + 64 * k;
    constexpr int RIN3 = IT_RIN / 3;
    const int extra = (k == 0) ? (IT_ROUT + RIN3) : (k == 1) ? (IT_SIN + IT_SOUT + RIN3) : (k == 2) ? RIN3 : 0;
    const int total = IT_FFIN + IT_FFOUT + extra;
    constexpr int QB = 8;
    for (;;) {
        unsigned it0 = 0u;
        if (F.lane == 0) it0 = __hip_atomic_fetch_add(head, (unsigned)QB, __ATOMIC_RELAXED, __HIP_MEMORY_SCOPE_AGENT);
        it0 = (unsigned)__builtin_amdgcn_readfirstlane((int)it0);
        if (it0 >= (unsigned)total) break;
        for (int q = 0; q < QB; ++q) {
            int r = (int)it0 + q; if (r >= total) break;
            if (r < IT_FFIN) { conv_one((const float*)ka->in[5] + (size_t)(k + 1) * D * 2 * DFF, (bf16_t*)(ws + WS_WFFIN + (size_t)(k + 1) * W_FFIN_SZ), D, 2 * DFF, 1, r, scr, F.lane); continue; }
            r -= IT_FFIN;
            if (r < IT_FFOUT) { conv_one((const float*)ka->in[6] + (size_t)(k + 1) * DFF * D, (bf16_t*)(ws + WS_WFFOUT + (size_t)(k + 1) * W_FFOUT_SZ), DFF, D, 0, r, scr, F.lane); continue; }
            r -= IT_FFOUT;
            if (k == 0 && r < IT_ROUT) { conv_one((const float*)ka->in[12], (bf16_t*)(ws + WS_WROUT), 2 * D, D, 0, r, scr, F.lane); continue; }
            if (k == 0) r -= IT_ROUT;
            if (k == 1 && r < IT_SIN) { conv_one((const float*)ka->in[13], (bf16_t*)(ws + WS_WSIN), D, SWA_N, 2, r, scr, F.lane); continue; }
            if (k == 1 && r < IT_SIN + IT_SOUT) { conv_one((const float*)ka->in[16], (bf16_t*)(ws + WS_WSOUT), D, D, 0, r - IT_SIN, scr, F.lane); continue; }
            if (k == 1) r -= IT_SIN + IT_SOUT;
            conv_one((const float*)ka->in[9], (bf16_t*)(ws + WS_WRIN), D, RET_N, 0, k * RIN3 + r, scr, F.lane);
        }
    }
}
__device__ __forceinline__ void sincos_dd(double ang, float& s, float& c) {
    const double q = rint(ang * 0.63661977236758134308);
    double r = fma(-q, 1.57079632679489655800e+00, ang); r = fma(-q, 6.12323399573676603587e-17, r);
    const int qi = (int)((long long)q & 3);
    const double r2 = r * r;
    double sp = -1.0 / 1307674368000.0; sp = fma(sp, r2, 1.0 / 6227020800.0); sp = fma(sp, r2, -1.0 / 39916800.0); sp = fma(sp, r2, 1.0 / 362880.0); sp = fma(sp, r2, -1.0 / 5040.0); sp = fma(sp, r2, 1.0 / 120.0); sp = fma(sp, r2, -1.0 / 6.0); sp = fma(sp * r2, r, r);
    double cp = 1.0 / 20922789888000.0; cp = fma(cp, r2, -1.0 / 87178291200.0); cp = fma(cp, r2, 1.0 / 479001600.0); cp = fma(cp, r2, -1.0 / 3628800.0); cp = fma(cp, r2, 1.0 / 40320.0); cp = fma(cp, r2, -1.0 / 720.0); cp = fma(cp, r2, 1.0 / 24.0); cp = fma(cp, r2, -0.5); cp = fma(cp, r2, 1.0);
    const double ss = (qi & 1) ? cp : sp, cc = (qi & 1) ? sp : cp;
    s = (float)((qi & 2) ? -ss : ss); c = (float)(((qi + 1) & 2) ? -cc : cc);
}
__device__ __forceinline__ void rope_tables(const Frame& F0, const int* pos, float* rc, float* rs, float* sc, float* ss) {
    const Frame F = relaunder(F0);
    const int gt = F.vcu * 512 + F.tid, NT = F.G * 512;
    for (int i = gt; i < M * 160; i += NT) {
        const int row = i / 160, j = i - row * 160;
        const double p = (double)pos[row];
        float s, c;
        if (j < 128) { const double invf = exp2(-(double)j * (13.287712379549449 / 127.0)); sincos_dd(p * invf, s, c); rc[(size_t)row * 128 + j] = c; rs[(size_t)row * 128 + j] = s; }
        else { const int jj = j - 128; const double invf = exp2(-(double)jj * (13.287712379549449 / 32.0)); sincos_dd(p * invf, s, c); sc[(size_t)row * 32 + jj] = c; ss[(size_t)row * 32 + jj] = s; }
    }
}

__device__ __forceinline__ void norm_phase(const Frame& F0, const float* hin, float* hout, const float* f, float alpha, const float* g1, const float* g2, bf16_t* u) {
    const Frame F = relaunder(F0);
    const int gw = F.vcu * 8 + F.wave, NGW = F.G * 8;
    for (int row = gw; row < M; row += NGW) {
        const f32x4* hr = (const f32x4*)(hin + (size_t)row * D) + F.lane;
        f32x4 hv[8];
#pragma unroll
        for (int j = 0; j < 8; ++j) hv[j] = hr[64 * j];
        if (f) {
            const f32x4* fr = (const f32x4*)(f + (size_t)row * D) + F.lane;
            f32x4 fv[8]; float ss = 0.f;
#pragma unroll
            for (int j = 0; j < 8; ++j) { fv[j] = fr[64 * j]; ss += (fv[j].x * fv[j].x + fv[j].y * fv[j].y) + (fv[j].z * fv[j].z + fv[j].w * fv[j].w); }
            const float rstd = alpha / sqrtf(wave_sum(ss) * (1.0f / D) + EPS);
#pragma unroll
            for (int j = 0; j < 8; ++j) { const f32x4 gv = ((const f32x4*)g1)[F.lane + 64 * j]; hv[j] = hv[j] + fv[j] * gv * rstd; }
        }
        if (hout) { f32x4* ho = (f32x4*)(hout + (size_t)row * D) + F.lane;
#pragma unroll
            for (int j = 0; j < 8; ++j) ho[64 * j] = hv[j]; }
        if (g2) {
            float ss = 0.f;
#pragma unroll
            for (int j = 0; j < 8; ++j) ss += (hv[j].x * hv[j].x + hv[j].y * hv[j].y) + (hv[j].z * hv[j].z + hv[j].w * hv[j].w);
            const float rstd = 1.0f / sqrtf(wave_sum(ss) * (1.0f / D) + EPS);
            u32x2* uo = (u32x2*)(u + (size_t)row * D) + F.lane;
#pragma unroll
            for (int j = 0; j < 8; ++j) { const f32x4 gv = ((const f32x4*)g2)[F.lane + 64 * j]; const f32x4 y = hv[j] * gv * rstd; u32x2 w; w.x = pk2(y.x, y.y); w.y = pk2(y.z, y.w); uo[64 * j] = w; }
        }
    }
}

__device__ __forceinline__ void pool_phase(const Frame& F0, const bf16_t* u, bf16_t* mixed) {
    const Frame F = relaunder(F0);
    const int gt = F.vcu * 512 + F.tid, NT = F.G * 512;
    for (int i = gt; i < M * (D / 8); i += NT) {
        const int row = i >> 8, c8 = i & 255, s = row & (SEQ - 1), w = 2 << (c8 >> 6);
        const int cnt = (s + 1 < w) ? (s + 1) : w;
        float a[8];
#pragma unroll
        for (int e = 0; e < 8; ++e) a[e] = 0.f;
        u32x4 self = (u32x4){0u, 0u, 0u, 0u};
        for (int k = 0; k < cnt; ++k) { const u32x4 v = *(const u32x4*)(u + (size_t)(row - k) * D + c8 * 8); if (k == 0) self = v;
            a[0] += bflo(v.x); a[1] += bfhi(v.x); a[2] += bflo(v.y); a[3] += bfhi(v.y); a[4] += bflo(v.z); a[5] += bfhi(v.z); a[6] += bflo(v.w); a[7] += bfhi(v.w); }
        const float inv = 1.0f / (float)cnt;
        u32x4 o;
        o.x = pk2(a[0] * inv - bflo(self.x), a[1] * inv - bfhi(self.x)); o.y = pk2(a[2] * inv - bflo(self.y), a[3] * inv - bfhi(self.y));
        o.z = pk2(a[4] * inv - bflo(self.z), a[5] * inv - bfhi(self.z)); o.w = pk2(a[6] * inv - bflo(self.w), a[7] * inv - bfhi(self.w));
        *(u32x4*)(mixed + (size_t)row * D + c8 * 8) = o;
    }
}

__device__ __forceinline__ void ds_tr4(unsigned a0, unsigned a1, unsigned a2, unsigned a3, bf16x8& f0, bf16x8& f1) {
    bf16x4 r0, r1, r2, r3;
    asm volatile("ds_read_b64_tr_b16 %0, %4\n\tds_read_b64_tr_b16 %1, %5\n\tds_read_b64_tr_b16 %2, %6\n\tds_read_b64_tr_b16 %3, %7\n\ts_waitcnt lgkmcnt(0)"
                 : "=&v"(r0), "=&v"(r1), "=&v"(r2), "=&v"(r3) : "v"(a0), "v"(a1), "v"(a2), "v"(a3) : "memory");
    f0 = __builtin_shufflevector(r0, r1, 0, 1, 2, 3, 4, 5, 6, 7); f1 = __builtin_shufflevector(r2, r3, 0, 1, 2, 3, 4, 5, 6, 7);
}
__device__ __forceinline__ bf16x8 pack8(const f32x4& a, const f32x4& b) {
    u32x4 w; w.x = pk2(a[0], a[1]); w.y = pk2(a[2], a[3]); w.z = pk2(b[0], b[1]); w.w = pk2(b[2], b[3]);
    return __builtin_bit_cast(bf16x8, w);
}

constexpr int RK_STR = 528, RV_STR = 80;
constexpr int R_KS = 0, R_VS = 128 * RK_STR, R_ST = R_VS + 128 * RV_STR, R_END = R_ST + 32 * RK_STR;
static_assert(R_END <= RING_BYTES, "retention LDS");
__device__ __forceinline__ void ret_core_phase(const Frame& F0, const bf16_t* hp, bf16_t* ro) {
    const Frame F = relaunder(F0);
    const int w = F.wave, lane = F.lane, l15 = lane & 15, g = lane >> 4, q = (lane & 15) >> 2, p = lane & 3;
    const unsigned ldsb = (unsigned)(size_t)F.lds;
    for (int item = F.vcu; item < 256; item += F.G) {
        const int b = item >> 7, hd = (item >> 4) & 7, vs = item & 15;
        const float l2g = log2_gamma(hd);
        const float g128 = __builtin_amdgcn_exp2f(128.0f * l2g);
        const bf16_t* qb = hp + (size_t)(b * SEQ) * RET_N + hd * 256;
        const bf16_t* kb = hp + (size_t)(b * SEQ) * RET_N + D + hd * 256;
        const bf16_t* vb = hp + (size_t)(b * SEQ) * RET_N + 2 * D + hd * 512 + vs * 32;
        bf16_t* ob = ro + (size_t)(b * SEQ) * 4096 + hd * 512 + vs * 32;
        f32x4 T[2][2];
#pragma unroll
        for (int a = 0; a < 2; ++a)
#pragma unroll
            for (int c = 0; c < 2; ++c) T[a][c] = (f32x4){0.f, 0.f, 0.f, 0.f};
        u32x4 kreg[8], vreg, qf[8];
#pragma unroll
        for (int i = 0; i < 8; ++i) { const int pc = F.tid + 512 * i, r = pc >> 5, c16 = pc & 31; kreg[i] = *(const u32x4*)(kb + (size_t)r * RET_N + c16 * 8); }
        { const int r = F.tid >> 2, c16 = F.tid & 3; vreg = *(const u32x4*)(vb + (size_t)r * RET_N + c16 * 8); }
#pragma unroll
        for (int ks = 0; ks < 8; ++ks) qf[ks] = *(const u32x4*)(qb + (size_t)(16 * w + l15) * RET_N + 32 * ks + 8 * g);
        for (int n = 0; n < 32; ++n) {
#pragma unroll
            for (int i = 0; i < 8; ++i) { const int pc = F.tid + 512 * i, r = pc >> 5, c16 = pc & 31; *(LAS u32x4*)(F.lds + R_KS + r * RK_STR + c16 * 16) = kreg[i]; }
            { const int r = F.tid >> 2, c16 = F.tid & 3; *(LAS u32x4*)(F.lds + R_VS + r * RV_STR + c16 * 16) = vreg; }
#pragma unroll
            for (int a = 0; a < 2; ++a)
#pragma unroll
                for (int c = 0; c < 2; ++c) { T[a][c] = T[a][c] * g128;
                    u32x2 wv; wv.x = pk2(T[a][c][0], T[a][c][1]); wv.y = pk2(T[a][c][2], T[a][c][3]);
                    *(LAS u32x2*)(F.lds + R_ST + (16 * c + l15) * RK_STR + (32 * w + 16 * a + 4 * g) * 2) = wv; }
            bf16x8 qc[8];
#pragma unroll
            for (int ks = 0; ks < 8; ++ks) qc[ks] = __builtin_bit_cast(bf16x8, qf[ks]);
            __syncthreads();
            { const int nn = (n + 1 < 32) ? n + 1 : n; const size_t ro0 = (size_t)(128 * nn) * RET_N;
#pragma unroll
              for (int i = 0; i < 8; ++i) { const int pc = F.tid + 512 * i, r = pc >> 5, c16 = pc & 31; kreg[i] = *(const u32x4*)(kb + ro0 + (size_t)r * RET_N + c16 * 8); }
              { const int r = F.tid >> 2, c16 = F.tid & 3; vreg = *(const u32x4*)(vb + ro0 + (size_t)r * RET_N + c16 * 8); }
#pragma unroll
              for (int ks = 0; ks < 8; ++ks) qf[ks] = *(const u32x4*)(qb + ro0 + (size_t)(16 * w + l15) * RET_N + 32 * ks + 8 * g); }
            f32x4 Pt[8];
#pragma unroll
            for (int jt = 0; jt < 8; ++jt) { Pt[jt] = (f32x4){0.f, 0.f, 0.f, 0.f};
                if (jt <= w) {
#pragma unroll
                    for (int ks = 0; ks < 8; ++ks) { const bf16x8 kf = *(const LAS bf16x8*)(F.lds + R_KS + (16 * jt + l15) * RK_STR + (32 * ks + 8 * g) * 2);
                        Pt[jt] = __builtin_amdgcn_mfma_f32_16x16x32_bf16(kf, qc[ks], Pt[jt], 0, 0, 0); }
                    if (jt == w) {
#pragma unroll
                        for (int r = 0; r < 4; ++r) if (4 * g + r > l15) Pt[jt][r] = 0.f; }
                } }
            f32x4 O[2];
#pragma unroll
            for (int vt = 0; vt < 2; ++vt) { O[vt] = (f32x4){0.f, 0.f, 0.f, 0.f};
#pragma unroll
                for (int ks = 0; ks < 8; ++ks) { const bf16x8 sf = *(const LAS bf16x8*)(F.lds + R_ST + (16 * vt + l15) * RK_STR + (32 * ks + 8 * g) * 2);
                    O[vt] = __builtin_amdgcn_mfma_f32_16x16x32_bf16(sf, qc[ks], O[vt], 0, 0, 0); } }
#pragma unroll
            for (int kk = 0; kk < 4; ++kk) {
                if (2 * kk <= w) {
                    const unsigned va = ldsb + R_VS + (32 * kk + 4 * g + q) * RV_STR + 4 * p * 2;
                    bf16x8 v0, v1; ds_tr4(va, va + 16 * RV_STR, va + 32, va + 16 * RV_STR + 32, v0, v1);
                    const bf16x8 pf = pack8(Pt[2 * kk], Pt[2 * kk + 1]);
                    O[0] = __builtin_amdgcn_mfma_f32_16x16x32_bf16(v0, pf, O[0], 0, 0, 0);
                    O[1] = __builtin_amdgcn_mfma_f32_16x16x32_bf16(v1, pf, O[1], 0, 0, 0);
                } }
            { bf16_t* orow = ob + (size_t)(128 * n + 16 * w + l15) * 4096;
#pragma unroll
              for (int vt = 0; vt < 2; ++vt) { u32x2 wv; wv.x = pk2(O[vt][0], O[vt][1]); wv.y = pk2(O[vt][2], O[vt][3]); *(u32x2*)(orow + 16 * vt + 4 * g) = wv; } }
#pragma unroll
            for (int kk = 0; kk < 4; ++kk) {
                const unsigned va = ldsb + R_VS + (32 * kk + 4 * g + q) * RV_STR + 4 * p * 2;
                const unsigned ka = ldsb + R_KS + (32 * kk + 4 * g + q) * RK_STR + (32 * w + 4 * p) * 2;
                bf16x8 v0, v1, k0, k1; ds_tr4(va, va + 16 * RV_STR, va + 32, va + 16 * RV_STR + 32, v0, v1);
                ds_tr4(ka, ka + 16 * RK_STR, ka + 32, ka + 16 * RK_STR + 32, k0, k1);
                T[0][0] = __builtin_amdgcn_mfma_f32_16x16x32_bf16(k0, v0, T[0][0], 0, 0, 0); T[0][1] = __builtin_amdgcn_mfma_f32_16x16x32_bf16(k0, v1, T[0][1], 0, 0, 0);
                T[1][0] = __builtin_amdgcn_mfma_f32_16x16x32_bf16(k1, v0, T[1][0], 0, 0, 0); T[1][1] = __builtin_amdgcn_mfma_f32_16x16x32_bf16(k1, v1, T[1][1], 0, 0, 0);
            }
            __syncthreads();
        }
    }
}

__device__ __forceinline__ void ret_gate_phase(const Frame& F0, const bf16_t* ro, const bf16_t* hp, const float* gng, const float* gnb, bf16_t* gt) {
    const Frame F = relaunder(F0);
    const int gw = F.vcu * 8 + F.wave, NGW = F.G * 8;
    for (int it = gw; it < M * 8; it += NGW) {
        const int row = it >> 3, hd = it & 7, c0 = hd * 512 + F.lane * 8;
        const u32x4 ov = *(const u32x4*)(ro + (size_t)row * 4096 + c0);
        const u32x4 gv = *(const u32x4*)(hp + (size_t)row * RET_N + 4 * D + c0);
        float o[8] = {bflo(ov.x), bfhi(ov.x), bflo(ov.y), bfhi(ov.y), bflo(ov.z), bfhi(ov.z), bflo(ov.w), bfhi(ov.w)};
        const float gg[8] = {bflo(gv.x), bfhi(gv.x), bflo(gv.y), bfhi(gv.y), bflo(gv.z), bfhi(gv.z), bflo(gv.w), bfhi(gv.w)};
        float s = 0.f;
#pragma unroll
        for (int e = 0; e < 8; ++e) s += o[e];
        const float mu = wave_sum(s) * (1.0f / 512.0f);
        float s2 = 0.f;
#pragma unroll
        for (int e = 0; e < 8; ++e) { o[e] -= mu; s2 += o[e] * o[e]; }
        const float rstd = 1.0f / sqrtf(wave_sum(s2) * (1.0f / 512.0f) + EPS);
        const f32x4 ga = *(const f32x4*)(gng + c0), gb = *(const f32x4*)(gng + c0 + 4), ba = *(const f32x4*)(gnb + c0), bb = *(const f32x4*)(gnb + c0 + 4);
        const float gn[8] = {ga[0], ga[1], ga[2], ga[3], gb[0], gb[1], gb[2], gb[3]}, bn[8] = {ba[0], ba[1], ba[2], ba[3], bb[0], bb[1], bb[2], bb[3]};
        float y[8];
#pragma unroll
        for (int e = 0; e < 8; ++e) y[e] = fast_silu(gg[e]) * (o[e] * rstd * gn[e] + bn[e]);
        u32x4 wv; wv.x = pk2(y[0], y[1]); wv.y = pk2(y[2], y[3]); wv.z = pk2(y[4], y[5]); wv.w = pk2(y[6], y[7]);
        *(u32x4*)(gt + (size_t)row * 4096 + c0) = wv;
    }
}

constexpr int SA_STR = 144;
constexpr int SA_KB = 0, SA_VB = 256 * SA_STR, SA_END = SA_VB + 272 * SA_STR;
static_assert(SA_END <= RING_BYTES, "swa LDS");
__device__ __forceinline__ void swa_attn_phase(const Frame& F0, const bf16_t* qkv, const float* sinks, bf16_t* ao) {
    const Frame F = relaunder(F0);
    const int w = F.wave, lane = F.lane, l15 = lane & 15, g = lane >> 4, q = (lane & 15) >> 2, p = lane & 3;
    const unsigned ldsb = (unsigned)(size_t)F.lds;
    for (int item = F.vcu; item < 256; item += F.G) {
        const int b = item >> 7, kvh = (item >> 5) & 3, nb = item & 31;
        const int hq = kvh * 8 + w;
        const float sink = sinks[hq];
        const int tok0 = b * SEQ + 128 * nb;
        __syncthreads();
#pragma unroll
        for (int i = 0; i < 4; ++i) { const int pc = F.tid + 512 * i, r = pc >> 3, c16 = pc & 7;
            unsigned z_ = 0u; asm volatile("" : "+v"(z_));
            u32x4 kv = (u32x4){z_, z_, z_, z_}, vv = kv;
            if (nb > 0 || r >= 128) { const bf16_t* src = qkv + (size_t)(tok0 - 128 + r) * SWA_N + 2048 + kvh * 64 + c16 * 8; kv = *(const u32x4*)src; vv = *(const u32x4*)(src + 256); }
            *(LAS u32x4*)(F.lds + SA_KB + r * SA_STR + c16 * 16) = kv; *(LAS u32x4*)(F.lds + SA_VB + r * SA_STR + c16 * 16) = vv; }
        if (F.tid < 128) { const int r = 256 + (F.tid >> 3), c16 = F.tid & 7; unsigned z_ = 0u; asm volatile("" : "+v"(z_)); *(LAS u32x4*)(F.lds + SA_VB + r * SA_STR + c16 * 16) = (u32x4){z_, z_, z_, z_}; }
        __syncthreads();
        for (int it = 0; it < 8; ++it) {
            const int row = tok0 + 16 * it + l15;
            bf16x8 qf[2];
#pragma unroll
            for (int ks = 0; ks < 2; ++ks) qf[ks] = __builtin_bit_cast(bf16x8, *(const u32x4*)(qkv + (size_t)row * SWA_N + hq * 64 + 32 * ks + 8 * g));
            f32x4 P[10];
            float mx = sink;
#pragma unroll
            for (int t = 0; t < 9; ++t) { const int jt = it + t; P[t] = (f32x4){0.f, 0.f, 0.f, 0.f};
#pragma unroll
                for (int ks = 0; ks < 2; ++ks) { const bf16x8 kf = *(const LAS bf16x8*)(F.lds + SA_KB + (16 * jt + l15) * SA_STR + (32 * ks + 8 * g) * 2);
                    P[t] = __builtin_amdgcn_mfma_f32_16x16x32_bf16(kf, qf[ks], P[t], 0, 0, 0); }
#pragma unroll
                for (int r = 0; r < 4; ++r) { const int jb = 16 * jt + 4 * g + r, diff = 16 * it + l15 + 128 - jb;
                    const bool ok = (diff >= 0) && (diff < 128) && (nb > 0 || jb >= 128);
                    const float sv = ok ? P[t][r] * 0.125f : -1e30f; P[t][r] = sv; mx = fmaxf(mx, sv); } }
            mx = fmaxf(mx, __shfl_xor(mx, 16)); mx = fmaxf(mx, __shfl_xor(mx, 32));
            float den = 0.f;
#pragma unroll
            for (int t = 0; t < 9; ++t)
#pragma unroll
                for (int r = 0; r < 4; ++r) { const float e = (P[t][r] > -1e29f) ? __builtin_amdgcn_exp2f((P[t][r] - mx) * 1.44269504089f) : 0.f; P[t][r] = e; den += e; }
            P[9] = (f32x4){0.f, 0.f, 0.f, 0.f};
            den += __shfl_xor(den, 16); den += __shfl_xor(den, 32);
            den += __builtin_amdgcn_exp2f((sink - mx) * 1.44269504089f);
            const float rden = 1.0f / den;
            f32x4 O[4];
#pragma unroll
            for (int dt = 0; dt < 4; ++dt) O[dt] = (f32x4){0.f, 0.f, 0.f, 0.f};
#pragma unroll
            for (int kk = 0; kk < 5; ++kk) {
                const bf16x8 pf = pack8(P[2 * kk], P[2 * kk + 1]);
                const unsigned va = ldsb + SA_VB + (16 * (it + 2 * kk) + 4 * g + q) * SA_STR + 4 * p * 2;
                bf16x8 v0, v1, v2, v3; ds_tr4(va, va + 16 * SA_STR, va + 32, va + 16 * SA_STR + 32, v0, v1); ds_tr4(va + 64, va + 16 * SA_STR + 64, va + 96, va + 16 * SA_STR + 96, v2, v3);
                O[0] = __builtin_amdgcn_mfma_f32_16x16x32_bf16(v0, pf, O[0], 0, 0, 0); O[1] = __builtin_amdgcn_mfma_f32_16x16x32_bf16(v1, pf, O[1], 0, 0, 0);
                O[2] = __builtin_amdgcn_mfma_f32_16x16x32_bf16(v2, pf, O[2], 0, 0, 0); O[3] = __builtin_amdgcn_mfma_f32_16x16x32_bf16(v3, pf, O[3], 0, 0, 0);
            }
            bf16_t* orow = ao + (size_t)row * D + hq * 64;
#pragma unroll
            for (int dt = 0; dt < 4; ++dt) { u32x2 wv; wv.x = pk2(O[dt][0] * rden, O[dt][1] * rden); wv.y = pk2(O[dt][2] * rden, O[dt][3] * rden); *(u32x2*)(orow + 16 * dt + 4 * g) = wv; }
        }
    }
}

constexpr int NPH = 61;
struct Args { const void* in[18]; float* out; unsigned char* ws; int ph_lo, ph_hi; };
typedef const Args __attribute__((address_space(4)))* KArgs;
__device__ __forceinline__ KArgs kargs() { KArgs p = (KArgs)__builtin_amdgcn_kernarg_segment_ptr(); asm volatile("" : "+s"(p)); return p; }
#define KIN(T, i) ((const T*)ka->in[i])
#define KWS(T, off) ((T*)(ka->ws + (off)))

__global__ void __launch_bounds__(512, 2) mk_fwd(Args args) {
    extern __shared__ __attribute__((aligned(16))) unsigned char lds_raw[];
    Frame F;
    F.lds = (LAS unsigned char*)lds_raw;
    F.tid = threadIdx.x; F.lane = F.tid & 63; F.wave = __builtin_amdgcn_readfirstlane(F.tid >> 6);
    F.G = gridDim.x; { const int bx = blockIdx.x; F.vcu = (F.G % 8 == 0) ? (bx % 8) * (F.G / 8) + bx / 8 : bx; }
    volatile LAS unsigned* MISC = (volatile LAS unsigned*)(F.lds + MISC_OFF);
    for (int u = F.tid; u < (LDS_BYTES - RING_BYTES) / 4; u += 512) ((LAS unsigned*)(F.lds + RING_BYTES))[u] = 0u;
    __syncthreads();
    const int lo = args.ph_lo, hi = args.ph_hi;
    XcdBarrier bar; bar.bar = (unsigned*)(args.ws + WS_CTL) + CW_BAR; bar.x = 0; bar.st = nullptr;
    if (hi - lo > 1) bar = xcd_barrier_post((unsigned*)(args.ws + WS_CTL) + CW_BAR, MISC + 8);
#define IN(k) (lo <= (k) && (k) < hi)
#define ENDP(k) do { if ((k) + 1 < hi) { _Pragma("nounroll") for (int rb_ = 0; rb_ < DUPN(7); ++rb_) { XcdBarrier bb_ = bar; asm volatile("" : "+s"(bb_.bar)); xcd_barrier(bb_); } } } while (0)

    if (IN(0)) {
#pragma nounroll
      for (int rp_ = 0; rp_ < DUPN(1); ++rp_) {
        { KArgs ka = kargs(); convert_stack(F, KIN(float, 5), KWS(bf16_t, WS_WFFIN), 1, D, 2 * DFF, 1); }
        { KArgs ka = kargs(); convert_stack(F, KIN(float, 6), KWS(bf16_t, WS_WFFOUT), 1, DFF, D, 0); }
        { KArgs ka = kargs(); convert_stack(F, KIN(float, 7), KWS(bf16_t, WS_WPOOL), 8, 512, 512, 0); }
        { KArgs ka = kargs(); rope_tables(F, KIN(int, 1), KWS(float, WS_RCOS), KWS(float, WS_RSIN), KWS(float, WS_SCOS), KWS(float, WS_SSIN)); }
        { KArgs ka = kargs(); norm_phase(F, KIN(float, 0), nullptr, nullptr, 0.f, nullptr, KIN(float, 2), KWS(bf16_t, WS_U)); }
      }
        ENDP(0);
    }

#pragma nounroll
    for (int L = 0; L < DEPTH; ++L) {
        const int pb = 1 + 16 * L, kind = L % 3;
#pragma nounroll
        for (int sub = 0; sub < 2; ++sub) {
            const int pf = pb + 9 * sub, wi = 2 * L + sub;
            if (IN(pf)) {
                KArgs ka = kargs();
                pg8::Gemm gm{KWS(bf16_t, WS_U), KWS(bf16_t, WS_WFFIN + (size_t)wi * W_FFIN_SZ), M, 2 * DFF, D, D, D};
                pg8::StaticOrder S; S.init(M, 2 * DFF, F.G, (int)blockIdx.x);
                pg8::EpiSwiglu E{KWS(bf16_t, WS_BIG), DFF};
if (DUPN(2) == 2) { pg8::gemm_phase<pg8::EpiSwiglu, pg8::StaticOrder>(F.lds, gm, S, E); }
                pg8::gemm_phase<pg8::EpiSwiglu, pg8::StaticOrder>(F.lds, gm, S, E);
                if (wi < 7) { convert_tail(F, kargs(), wi); }
                ENDP(pf);
            }
            if (IN(pf + 1)) {
                KArgs ka = kargs();
                pg8::Gemm gm{KWS(bf16_t, WS_BIG), KWS(bf16_t, WS_WFFOUT + (size_t)wi * W_FFOUT_SZ), M, D, DFF, DFF, DFF};
                pg8::StaticOrder S; S.init(M, D, F.G, (int)blockIdx.x);
                pg8::EpiF32 E{KWS(float, WS_F), D, nullptr, nullptr};
if (DUPN(3) == 2) { pg8::gemm_phase<pg8::EpiF32, pg8::StaticOrder>(F.lds, gm, S, E); }
                pg8::gemm_phase<pg8::EpiF32, pg8::StaticOrder>(F.lds, gm, S, E);
                ENDP(pf + 1);
            }
            if (IN(pf + 2)) {
                KArgs ka = kargs();
                const float* gpost = (sub == 0 ? KIN(float, 2) : KIN(float, 4)) + (size_t)(L * 2 + 1) * D;
                const float* gnext = (sub == 0) ? KIN(float, 3) + (size_t)(L * 2) * D : (L + 1 < DEPTH ? KIN(float, 2) + (size_t)((L + 1) * 2) * D : nullptr);
                const float* hin = (L == 0 && sub == 0) ? KIN(float, 0) : KWS(float, WS_H);
                float* hout = (L + 1 == DEPTH && sub == 1) ? ka->out : KWS(float, WS_H);
                if (DUPN(4) == 2) norm_phase(F, hin, KWS(float, WS_RO), KWS(float, WS_F), 0.5f, gpost, gnext, KWS(bf16_t, WS_GT));
                norm_phase(F, hin, hout, KWS(float, WS_F), 0.5f, gpost, gnext, KWS(bf16_t, WS_U));
                ENDP(pf + 2);
            }
            if (sub == 0) {
                const int pm = pb + 3;
                if (kind == 0) {
                    if (IN(pm)) { KArgs ka = kargs();
if (DUPN(6) == 2) { pool_phase(F, KWS(bf16_t, WS_U), KWS(bf16_t, WS_X2)); }
                pool_phase(F, KWS(bf16_t, WS_U), KWS(bf16_t, WS_X2)); ENDP(pm); }
                } else if (kind == 1) {
                    if (IN(pm)) {
                        KArgs ka = kargs();
                        pg8::Gemm gm{KWS(bf16_t, WS_U), KWS(bf16_t, WS_WRIN), M, RET_N, D, D, D};
                        pg8::StaticOrder S; S.init(M, RET_N, F.G, (int)blockIdx.x);
                        pg8::EpiRetIn E{KWS(bf16_t, WS_BIG), KWS(float, WS_RCOS), KWS(float, WS_RSIN)};
if (DUPN(6) == 2) { pg8::gemm_phase<pg8::EpiRetIn, pg8::StaticOrder>(F.lds, gm, S, E); }
                pg8::gemm_phase<pg8::EpiRetIn, pg8::StaticOrder>(F.lds, gm, S, E);
                        ENDP(pm);
                    }
                    if (IN(pm + 1)) { KArgs ka = kargs();
if (DUPN(5) == 2) { ret_core_phase(F, KWS(bf16_t, WS_BIG), KWS(bf16_t, WS_RO)); }
                ret_core_phase(F, KWS(bf16_t, WS_BIG), KWS(bf16_t, WS_RO)); ENDP(pm + 1); }
                    if (IN(pm + 2)) { KArgs ka = kargs();
if (DUPN(6) == 2) { ret_gate_phase(F, KWS(bf16_t, WS_RO), KWS(bf16_t, WS_BIG), KIN(float, 10), KIN(float, 11), KWS(bf16_t, WS_GT)); }
                ret_gate_phase(F, KWS(bf16_t, WS_RO), KWS(bf16_t, WS_BIG), KIN(float, 10), KIN(float, 11), KWS(bf16_t, WS_GT)); ENDP(pm + 2); }
                } else {
                    if (IN(pm)) {
                        KArgs ka = kargs();
                        pg8::Gemm gm{KWS(bf16_t, WS_U), KWS(bf16_t, WS_WSIN), M, SWA_N, D, D, D};
                        pg8::StaticOrder S; S.init(M, SWA_N, F.G, (int)blockIdx.x);
                        pg8::EpiSwaIn E{KWS(bf16_t, WS_BIG), KIN(float, 14), KWS(float, WS_SCOS), KWS(float, WS_SSIN)};
if (DUPN(6) == 2) { pg8::gemm_phase<pg8::EpiSwaIn, pg8::StaticOrder>(F.lds, gm, S, E); }
                pg8::gemm_phase<pg8::EpiSwaIn, pg8::StaticOrder>(F.lds, gm, S, E);
                        ENDP(pm);
                    }
                    if (IN(pm + 1)) { KArgs ka = kargs();
if (DUPN(6) == 2) { swa_attn_phase(F, KWS(bf16_t, WS_BIG), KIN(float, 15), KWS(bf16_t, WS_X2)); }
                swa_attn_phase(F, KWS(bf16_t, WS_BIG), KIN(float, 15), KWS(bf16_t, WS_X2)); ENDP(pm + 1); }
                }
                if (IN(pb + 7)) {
                    KArgs ka = kargs();
                    const int jm = L / 3;
                    pg8::Gemm gm; pg8::StaticOrder S; pg8::EpiF32 E{KWS(float, WS_F), D, nullptr, nullptr};
                    if (kind == 0) { gm = pg8::Gemm{KWS(bf16_t, WS_X2), KWS(bf16_t, WS_WPOOL + (size_t)jm * D * 512 * 2), M, D, 512, D, 512}; S.init(M, D, F.G, (int)blockIdx.x, 512); E.scale = KIN(float, 8) + (size_t)jm * D; }
                    else if (kind == 1) { gm = pg8::Gemm{KWS(bf16_t, WS_GT), KWS(bf16_t, WS_WROUT), M, D, 2 * D, 2 * D, 2 * D}; S.init(M, D, F.G, (int)blockIdx.x); }
                    else { gm = pg8::Gemm{KWS(bf16_t, WS_X2), KWS(bf16_t, WS_WSOUT), M, D, D, D, D}; S.init(M, D, F.G, (int)blockIdx.x); E.bias = KIN(float, 17); }
if (DUPN(6) == 2) { pg8::gemm_phase<pg8::EpiF32, pg8::StaticOrder>(F.lds, gm, S, E); }
                pg8::gemm_phase<pg8::EpiF32, pg8::StaticOrder>(F.lds, gm, S, E);
                    ENDP(pb + 7);
                }
                if (IN(pb + 8)) {
                    KArgs ka = kargs();
                    if (DUPN(4) == 2) norm_phase(F, KWS(float, WS_H), KWS(float, WS_RO), KWS(float, WS_F), 1.0f, KIN(float, 3) + (size_t)(L * 2 + 1) * D, KIN(float, 4) + (size_t)(L * 2) * D, KWS(bf16_t, WS_GT));
                    norm_phase(F, KWS(float, WS_H), KWS(float, WS_H), KWS(float, WS_F), 1.0f, KIN(float, 3) + (size_t)(L * 2 + 1) * D, KIN(float, 4) + (size_t)(L * 2) * D, KWS(bf16_t, WS_U));
                    ENDP(pb + 8);
                }
            }
        }
    }
#undef IN
#undef ENDP
}

static bool phase_exists(int p) {
    if (p == 0) return true;
    const int L = (p - 1) / 16, s = (p - 1) % 16, kind = L % 3;
    if (s <= 2 || (s >= 7 && s <= 11)) return true;
    if (s == 3) return true;
    if (s == 4) return kind != 0;
    if (s == 5) return kind == 1;
    return false;
}
extern "C" void kernel_launch(void* const* d_in, const int* in_sizes, int n_in, void* d_out, int out_size, void* d_ws, size_t ws_size, hipStream_t stream) {
    static int grid = 0;
    if (grid == 0) {
        if (n_in != 18 || in_sizes[0] != M * D || out_size != M * D || ws_size < WS_END) { fprintf(stderr, "kernel_launch: unexpected problem (n_in %d, in0 %d, out %d, ws %zu, need %zu)\n", n_in, n_in > 0 ? in_sizes[0] : -1, out_size, ws_size, (size_t)WS_END); grid = -1; return; }
        int dev = 0, cus = 0, per_cu = 0;
        if (hipGetDevice(&dev) != hipSuccess || hipDeviceGetAttribute(&cus, hipDeviceAttributeMultiprocessorCount, dev) != hipSuccess) { grid = -1; return; }
        if (hipFuncSetAttribute((const void*)mk_fwd, hipFuncAttributeMaxDynamicSharedMemorySize, LDS_BYTES) != hipSuccess) { fprintf(stderr, "kernel_launch: hipFuncSetAttribute failed\n"); grid = -1; return; }
        if (hipOccupancyMaxActiveBlocksPerMultiprocessor(&per_cu, (const void*)mk_fwd, 512, LDS_BYTES) != hipSuccess || per_cu < 1) fprintf(stderr, "kernel_launch: occupancy query says %d blocks per CU\n", per_cu);
        (void)hipGetLastError();
        grid = cus;
    }
    if (grid < 0) return;
    if (hipMemsetAsync((char*)d_ws + WS_CTL, 0, CTL_ZERO_BYTES, stream) != hipSuccess) return;
    Args a{};
    for (int i = 0; i < 18; ++i) a.in[i] = d_in[i];
    a.out = (float*)d_out; a.ws = (unsigned char*)d_ws;
#if MK_MEGA
    a.ph_lo = 0; a.ph_hi = NPH;
    hipLaunchKernelGGL(mk_fwd, dim3(grid), dim3(512), LDS_BYTES, stream, a);
#else
    for (int p = 0; p < NPH; ++p) { if (!phase_exists(p)) continue; a.ph_lo = p; a.ph_hi = p + 1; hipLaunchKernelGGL(mk_fwd, dim3(grid), dim3(512), LDS_BYTES, stream, a); }
#endif
}
```
